# Optimizing an MI355X kernel written in HIP

```python
import math
import jax, jax.numpy as jnp
from jax import lax
import numpy as np

D_MODEL = 1024
BATCH = 4
SEQ = 4096
DEPTH = 2

HEAD_DIM = 64
BRANCH_WIDTH = D_MODEL // 2
N_BRANCHES = 4
Q_BLOCK = 128
FOX_HEADS = BRANCH_WIDTH // HEAD_DIM
LRU_BLOCKS = 8
LRU_BLOCK_DIM = BRANCH_WIDTH // LRU_BLOCKS
CONV_WIDTH = 4
LRU_C = 8.0
NSA_HEADS = BRANCH_WIDTH // HEAD_DIM
NSA_KV_HEADS = 2
NSA_GROUP = NSA_HEADS // NSA_KV_HEADS
NSA_KV_WIDTH = NSA_KV_HEADS * HEAD_DIM
CMP_BLOCK = 32
CMP_STRIDE = 16
CMP_HIDDEN = 2 * HEAD_DIM
SLC_BLOCK = 64
SLC_TOPK = 16
SLC_LOCAL = 2
SLC_FORCE_SCORE = 1e6
WINDOW = 512
SG_CHUNK = 128
SG_GROUPS = 8
SG_GROUP_DIM = BRANCH_WIDTH // SG_GROUPS

NORM_EPS = 1e-6
NEG_INF = -1e30

kernel_name = "hybrid_fox_rglru_nsa_sgmlp_block"


def _in_split_sizes():
    W = BRANCH_WIDTH
    return (W, W, W, FOX_HEADS, W,
            W, W,
            W, NSA_KV_WIDTH, NSA_KV_WIDTH, NSA_KV_WIDTH,
            NSA_KV_WIDTH, NSA_KV_WIDTH, NSA_KV_WIDTH,
            3 * NSA_HEADS, W,
            W, W, W,
            N_BRANCHES * D_MODEL)


def rms_norm(x, g):
    x32 = x.astype(jnp.float32)
    y = x32 * lax.rsqrt(jnp.mean(x32 * x32, axis=-1, keepdims=True) + NORM_EPS)
    return (y * g.astype(jnp.float32)).astype(x.dtype)


def layer_norm(x, g):
    x32 = x.astype(jnp.float32)
    mu = jnp.mean(x32, axis=-1, keepdims=True)
    xc = x32 - mu
    y = xc * lax.rsqrt(jnp.mean(xc * xc, axis=-1, keepdims=True) + NORM_EPS)
    return (y * g.astype(jnp.float32)).astype(x.dtype)


def masked_softmax(s, mask):
    p = jax.nn.softmax(jnp.where(mask, s, NEG_INF), axis=-1)
    return jnp.where(mask, p, 0.0)


def fox_attention(q, k, v, f_logit):
    B, S, H, dh = q.shape
    n_blk = S // Q_BLOCK
    scale = 1.0 / math.sqrt(dh)
    c = jnp.cumsum(jax.nn.log_sigmoid(f_logit.astype(jnp.float32)), axis=1)
    c_k = c.transpose(0, 2, 1)[:, :, None, :]
    qb = q.reshape(B, n_blk, Q_BLOCK, H, dh).transpose(1, 0, 2, 3, 4)
    cb = c.reshape(B, n_blk, Q_BLOCK, H).transpose(1, 0, 2, 3)
    pos_k = jnp.arange(S)

    def block(args):
        q_i, c_i, i = args
        t = i * Q_BLOCK + jnp.arange(Q_BLOCK)
        s = jnp.einsum('bqhd,bkhd->bhqk', q_i, k).astype(jnp.float32) * scale
        s = s + c_i.transpose(0, 2, 1)[..., None] - c_k
        p = masked_softmax(s, pos_k[None, :] <= t[:, None])
        return jnp.einsum('bhqk,bkhd->bqhd', p.astype(v.dtype), v)

    out = lax.map(block, (qb, cb, jnp.arange(n_blk)))
    return out.transpose(1, 0, 2, 3, 4).reshape(B, S, H, dh)


def rg_lru(xb, conv_w, conv_b, w_a, b_a, w_x, b_x, lam):
    B, S, W = xb.shape
    xc = lax.conv_general_dilated(
        xb, conv_w.reshape(CONV_WIDTH, 1, W).astype(xb.dtype), window_strides=(1,),
        padding=[(CONV_WIDTH - 1, 0)], dimension_numbers=('NWC', 'WIO', 'NWC'),
        feature_group_count=W) + conv_b
    xh = xc.reshape(B, S, LRU_BLOCKS, LRU_BLOCK_DIM)
    r = jax.nn.sigmoid((jnp.einsum('bsnd,nde->bsne', xh, w_a).reshape(B, S, W) + b_a).astype(jnp.float32))
    i_g = jax.nn.sigmoid((jnp.einsum('bsnd,nde->bsne', xh, w_x).reshape(B, S, W) + b_x).astype(jnp.float32))
    log_a = -LRU_C * r * jax.nn.softplus(-lam.astype(jnp.float32))
    a = jnp.exp(log_a)
    b = jnp.sqrt(-jnp.expm1(2.0 * log_a)) * (i_g * xc.astype(jnp.float32))

    def combine(left, right):
        a_l, b_l = left
        a_r, b_r = right
        return a_l * a_r, a_r * b_l + b_r

    _, h = lax.associative_scan(combine, (a, b), axis=1)
    return h.astype(xb.dtype)


def _cmp_slc_overlap(n_cmp, n_slc):
    c0 = np.arange(n_cmp) * CMP_STRIDE
    s0 = np.arange(n_slc) * SLC_BLOCK
    ov = np.minimum(c0[:, None] + CMP_BLOCK, s0[None, :] + SLC_BLOCK) - np.maximum(c0[:, None], s0[None, :])
    return (np.clip(ov, 0, None) / CMP_BLOCK).astype(np.float32)


def nsa_attention(q, k_cmp, v_cmp, k_slc, v_slc, k_win, v_win, gates,
                  kn_g, cmp_pos, wk1, wk2, wv1, wv2):
    B, S, H, dh = q.shape
    G, R = NSA_KV_HEADS, NSA_GROUP
    scale = 1.0 / math.sqrt(dh)
    n_cmp = (S - CMP_BLOCK) // CMP_STRIDE + 1
    blk_idx = np.arange(n_cmp)[:, None] * CMP_STRIDE + np.arange(CMP_BLOCK)[None, :]
    cmp_end = jnp.asarray(blk_idx[:, -1])

    def compress(t, w1, w2):
        tb = t[:, blk_idx] + cmp_pos[None, None, :, None, :]
        tb = tb.transpose(0, 1, 3, 2, 4).reshape(B, n_cmp, G, CMP_BLOCK * dh)
        return jax.nn.silu(tb @ w1) @ w2

    k_c = rms_norm(compress(k_cmp, wk1, wk2), kn_g)
    v_c = compress(v_cmp, wv1, wv2)
    n_slc = S // SLC_BLOCK
    top_k = min(SLC_TOPK, n_slc)
    overlap = jnp.asarray(_cmp_slc_overlap(n_cmp, n_slc))
    ks_blk = rms_norm(k_slc, kn_g).reshape(B, n_slc, SLC_BLOCK, G, dh).transpose(0, 3, 1, 2, 4)
    vs_blk = v_slc.reshape(B, n_slc, SLC_BLOCK, G, dh).transpose(0, 3, 1, 2, 4)
    kw_pad = jnp.pad(rms_norm(k_win, kn_g), ((0, 0), (WINDOW, 0), (0, 0), (0, 0)))
    vw_pad = jnp.pad(v_win, ((0, 0), (WINDOW, 0), (0, 0), (0, 0)))
    span = WINDOW + Q_BLOCK

    n_blk = S // Q_BLOCK
    qg = q.reshape(B, n_blk, Q_BLOCK, G, R, dh).transpose(1, 0, 2, 3, 4, 5)
    gb = gates.reshape(B, n_blk, Q_BLOCK, 3, H).transpose(1, 0, 2, 3, 4)
    b_ix = jnp.arange(B)[:, None, None, None]
    g_ix = jnp.arange(G)[None, :, None, None]
    j = jnp.arange(n_slc)

    def block(args):
        q_i, g_i, i = args
        t = i * Q_BLOCK + jnp.arange(Q_BLOCK)
        s_c = jnp.einsum('bqgrd,bcgd->bgrqc', q_i, k_c).astype(jnp.float32) * scale
        p_c = masked_softmax(s_c, cmp_end[None, :] <= t[:, None])
        o_c = jnp.einsum('bgrqc,bcgd->bqgrd', p_c.astype(v_c.dtype), v_c)
        imp = jnp.einsum('bgrqc,cj->bgqj', p_c, overlap)
        jt = t // SLC_BLOCK
        valid = j[None, :] <= jt[:, None]
        forced = (j[None, :] == 0) | (valid & (j[None, :] > jt[:, None] - SLC_LOCAL))
        score = jnp.where(forced, SLC_FORCE_SCORE, jnp.where(valid, imp, -1.0))
        top_val, top_idx = lax.top_k(score, top_k)
        k_sel = ks_blk[b_ix, g_ix, top_idx]
        v_sel = vs_blk[b_ix, g_ix, top_idx]
        key_pos = top_idx[..., None] * SLC_BLOCK + jnp.arange(SLC_BLOCK)
        m_s = (top_val >= 0.0)[..., None] & (key_pos <= t[None, None, :, None, None])
        s_s = jnp.einsum('bqgrd,bgqkld->bgrqkl', q_i, k_sel).astype(jnp.float32) * scale
        n_sel = top_k * SLC_BLOCK
        p_s = masked_softmax(s_s.reshape(B, G, R, Q_BLOCK, n_sel), m_s.reshape(B, G, 1, Q_BLOCK, n_sel))
        o_s = jnp.einsum('bgrqn,bgqnd->bqgrd', p_s.astype(v_sel.dtype),
                         v_sel.reshape(B, G, Q_BLOCK, n_sel, dh))
        k_wi = lax.dynamic_slice_in_dim(kw_pad, i * Q_BLOCK, span, axis=1)
        v_wi = lax.dynamic_slice_in_dim(vw_pad, i * Q_BLOCK, span, axis=1)
        pos_w = i * Q_BLOCK - WINDOW + jnp.arange(span)
        m_w = (pos_w[None, :] >= 0) & (pos_w[None, :] <= t[:, None]) & (pos_w[None, :] > t[:, None] - WINDOW)
        s_w = jnp.einsum('bqgrd,bkgd->bgrqk', q_i, k_wi).astype(jnp.float32) * scale
        p_w = masked_softmax(s_w, m_w)
        o_w = jnp.einsum('bgrqk,bkgd->bqgrd', p_w.astype(v_wi.dtype), v_wi)
        g = g_i.reshape(B, Q_BLOCK, 3, G, R)[..., None]
        return g[:, :, 0] * o_c + g[:, :, 1] * o_s + g[:, :, 2] * o_w

    out = lax.map(block, (qg, gb, jnp.arange(n_blk)))
    return out.transpose(1, 0, 2, 3, 4, 5).reshape(B, S, H * dh)


def spatial_gating(u, v, ln_g, w_s, b_s):
    B, S, W = u.shape
    n_chunk = S // SG_CHUNK
    u = jax.nn.gelu(u, approximate=False)
    v = layer_norm(jax.nn.gelu(v, approximate=False), ln_g)
    vc = v.reshape(B, n_chunk, SG_CHUNK, SG_GROUPS, SG_GROUP_DIM)
    causal = jnp.tril(jnp.ones((SG_CHUNK, SG_CHUNK), dtype=w_s.dtype))
    mixed = jnp.einsum('gts,bcsgd->bctgd', w_s * causal, vc) + b_s.T[None, None, :, :, None]
    return u * mixed.reshape(B, S, W)


def hybrid_layer(x, norm_g, w_in, b_forget, qn_a, kn_a, conv_w, conv_b, w_rg_a, b_rg_a,
                 w_rg_x, b_rg_x, lru_lambda, qn_c, kn_c, cmp_pos, cmp_k_w1, cmp_k_w2,
                 cmp_v_w1, cmp_v_w2, ln_v_g, w_spatial, b_spatial, w_branch, w_out):
    B, S, D = x.shape
    W = BRANCH_WIDTH
    xn = rms_norm(x, norm_g)
    z = xn @ w_in
    split_at = np.cumsum(_in_split_sizes())[:-1].tolist()
    (qa, ka, va, fa, ga, xb, gb, qc, kcc, vcc, ksc, vsc, kwc, vwc, gate_c, gc,
     ud, vd, gd, mg) = jnp.split(z, split_at, axis=-1)
    heads = lambda t, n: t.reshape(B, S, n, HEAD_DIM)
    y_a = fox_attention(rms_norm(heads(qa, FOX_HEADS), qn_a), rms_norm(heads(ka, FOX_HEADS), kn_a),
                        heads(va, FOX_HEADS), fa + b_forget).reshape(B, S, W)
    y_b = rg_lru(xb, conv_w, conv_b, w_rg_a, b_rg_a, w_rg_x, b_rg_x, lru_lambda)
    y_c = nsa_attention(rms_norm(heads(qc, NSA_HEADS), qn_c),
                        heads(kcc, NSA_KV_HEADS), heads(vcc, NSA_KV_HEADS),
                        heads(ksc, NSA_KV_HEADS), heads(vsc, NSA_KV_HEADS),
                        heads(kwc, NSA_KV_HEADS), heads(vwc, NSA_KV_HEADS),
                        jax.nn.sigmoid(gate_c).reshape(B, S, 3, NSA_HEADS),
                        kn_c, cmp_pos, cmp_k_w1, cmp_k_w2, cmp_v_w1, cmp_v_w2)
    y_d = spatial_gating(ud, vd, ln_v_g, w_spatial, b_spatial)
    ys = jnp.stack([y_a * jax.nn.silu(ga), y_b * jax.nn.silu(gb),
                    y_c * jax.nn.silu(gc), y_d * jax.nn.silu(gd)], axis=2)
    proj = jnp.einsum('bsnw,nwd->bsnd', ys, w_branch)
    merged = jnp.sum(jax.nn.sigmoid(mg.reshape(B, S, N_BRANCHES, D)) * proj, axis=2)
    return x + merged @ w_out


def setup_inputs(seed: int = 0) -> dict:
    key = jax.random.key(seed)
    ks = iter(jax.random.split(key, 32))
    L, D, W, dh = DEPTH, D_MODEL, BRANCH_WIDTH, HEAD_DIM

    def nrm(shape, scale):
        return jax.random.normal(next(ks), shape, jnp.float32) * scale

    w_in_width = sum(_in_split_sizes())
    x = nrm((BATCH, SEQ, D), 1.0)
    norm_g = 1.0 + nrm((L, D), 0.05)
    w_in = nrm((L, D, w_in_width), D ** -0.5)
    b_forget = 3.0 + nrm((L, FOX_HEADS), 0.5)
    qn_a = 1.0 + nrm((L, dh), 0.05)
    kn_a = 1.0 + nrm((L, dh), 0.05)
    conv_w = nrm((L, CONV_WIDTH, W), CONV_WIDTH ** -0.5)
    conv_b = nrm((L, W), 0.01)
    w_rg_a = nrm((L, LRU_BLOCKS, LRU_BLOCK_DIM, LRU_BLOCK_DIM), LRU_BLOCK_DIM ** -0.5)
    b_rg_a = nrm((L, W), 0.01)
    w_rg_x = nrm((L, LRU_BLOCKS, LRU_BLOCK_DIM, LRU_BLOCK_DIM), LRU_BLOCK_DIM ** -0.5)
    b_rg_x = nrm((L, W), 0.01)
    a_c = jax.random.uniform(next(ks), (L, W), jnp.float32, 0.9, 0.999)
    a0 = a_c ** (1.0 / LRU_C)
    lru_lambda = jnp.log(a0) - jnp.log1p(-a0)
    qn_c = 1.0 + nrm((L, dh), 0.05)
    kn_c = 1.0 + nrm((L, dh), 0.05)
    cmp_pos = nrm((L, CMP_BLOCK, dh), 0.02)
    cmp_k_w1 = nrm((L, CMP_BLOCK * dh, CMP_HIDDEN), (CMP_BLOCK * dh) ** -0.5)
    cmp_k_w2 = nrm((L, CMP_HIDDEN, dh), CMP_HIDDEN ** -0.5)
    cmp_v_w1 = nrm((L, CMP_BLOCK * dh, CMP_HIDDEN), (CMP_BLOCK * dh) ** -0.5)
    cmp_v_w2 = nrm((L, CMP_HIDDEN, dh), CMP_HIDDEN ** -0.5)
    ln_v_g = 1.0 + nrm((L, W), 0.05)
    w_spatial = nrm((L, SG_GROUPS, SG_CHUNK, SG_CHUNK), SG_CHUNK ** -0.5)
    b_spatial = 1.0 + nrm((L, SG_GROUPS, SG_CHUNK), 0.1)
    w_branch = nrm((L, N_BRANCHES, W, D), W ** -0.5)
    w_out = nrm((L, D, D), D ** -0.5)
    return {"x": x, "norm_g": norm_g, "w_in": w_in, "b_forget": b_forget, "qn_a": qn_a,
            "kn_a": kn_a, "conv_w": conv_w, "conv_b": conv_b, "w_rg_a": w_rg_a,
            "b_rg_a": b_rg_a, "w_rg_x": w_rg_x, "b_rg_x": b_rg_x, "lru_lambda": lru_lambda,
            "qn_c": qn_c, "kn_c": kn_c, "cmp_pos": cmp_pos, "cmp_k_w1": cmp_k_w1,
            "cmp_k_w2": cmp_k_w2, "cmp_v_w1": cmp_v_w1, "cmp_v_w2": cmp_v_w2,
            "ln_v_g": ln_v_g, "w_spatial": w_spatial, "b_spatial": b_spatial,
            "w_branch": w_branch, "w_out": w_out}


def reference(x, norm_g, w_in, b_forget, qn_a, kn_a, conv_w, conv_b, w_rg_a, b_rg_a,
              w_rg_x, b_rg_x, lru_lambda, qn_c, kn_c, cmp_pos, cmp_k_w1, cmp_k_w2,
              cmp_v_w1, cmp_v_w2, ln_v_g, w_spatial, b_spatial, w_branch, w_out):
    for l in range(DEPTH):
        x = hybrid_layer(x, norm_g[l], w_in[l], b_forget[l], qn_a[l], kn_a[l], conv_w[l],
                         conv_b[l], w_rg_a[l], b_rg_a[l], w_rg_x[l], b_rg_x[l], lru_lambda[l],
                         qn_c[l], kn_c[l], cmp_pos[l], cmp_k_w1[l], cmp_k_w2[l], cmp_v_w1[l],
                         cmp_v_w2[l], ln_v_g[l], w_spatial[l], b_spatial[l], w_branch[l], w_out[l])
    return x
```

```cpp
#include <hip/hip_runtime.h>
#include <hip/hip_cooperative_groups.h>
#include <cstdio>
namespace cg = cooperative_groups;

typedef unsigned short u16;
typedef unsigned long long u64;
typedef short bf16x8 __attribute__((ext_vector_type(8)));
typedef short s16x4 __attribute__((ext_vector_type(4)));
typedef float f32x16 __attribute__((ext_vector_type(16)));
typedef __bf16 bf2_t __attribute__((ext_vector_type(2)));
typedef float f2_t __attribute__((ext_vector_type(2)));

#define DI __device__ __forceinline__
#define MFMA(a, b, c) __builtin_amdgcn_mfma_f32_32x32x16_bf16((a), (b), (c), 0, 0, 0)

#define S_ 4096
#define T_ 16384
#define ZS 6528
#define QA 0
#define KA 512
#define VA 1024
#define GA 1536
#define XB 2048
#define GB 2560
#define QC 3072
#define KCC 3584
#define VCC 3712
#define KSC 3840
#define VSC 3968
#define KWC 4096
#define VWC 4224
#define GC 4352
#define UD 4864
#define VD 5376
#define GD 5888
#define FA 6400
#define GATEC 6408
#define LOG2E 1.4426950408889634f
#define QSCALE (0.125f * LOG2E)
#define NEGBIG (-1e30f)
#define LDS_BYTES 73728

struct Params {
  const float *x, *norm_g, *w_in, *b_forget, *qn_a, *kn_a, *conv_w, *conv_b, *w_rg_a, *b_rg_a, *w_rg_x, *b_rg_x,
      *lru_lambda, *qn_c, *kn_c, *cmp_pos, *cmp_k_w1, *cmp_k_w2, *cmp_v_w1, *cmp_v_w2, *ln_v_g, *w_spatial,
      *b_spatial, *w_branch, *w_out;
  float* out;
  int* ctr;
  u16 *z, *xn, *WinT, *WgT, *WbT, *WoT;
  float *cbuf, *lrusum;
  u16 *kc, *vc;
  uint4* blkscr;
};

DI unsigned pk2(float a, float b) { f2_t v = {a, b}; bf2_t r = __builtin_convertvector(v, bf2_t); return __builtin_bit_cast(unsigned, r); }
DI float bflo(unsigned u) { return __uint_as_float(u << 16); }
DI float bfhi(unsigned u) { return __uint_as_float(u & 0xffff0000u); }
DI float bf2f(u16 v) { return __uint_as_float(((unsigned)v) << 16); }
DI u16 f2bf(float x) { return (u16)(pk2(x, 0.f) & 0xffffu); }
DI float sigmoidf_(float x) { return 1.f / (1.f + __expf(-x)); }
DI float siluf_(float x) { return x / (1.f + __expf(-x)); }
DI float geluf_(float x) { return 0.5f * x * (1.f + erff(x * 0.70710678118654752f)); }
DI float wave_sum(float v) {
#pragma unroll
  for (int o = 32; o > 0; o >>= 1) v += __shfl_xor(v, o);
  return v;
}
DI int TID() { int t = threadIdx.x; asm volatile("" : "+v"(t)); return t; }
DI int pop_item(int* ctr, int* slot) {
  __syncthreads();
  if (threadIdx.x == 0) *slot = atomicAdd(ctr, 1);
  __syncthreads();
  return *slot;
}

#define LDT 72
DI void gemm_mainloop(const u16* __restrict__ Ag, int lda, const u16* __restrict__ Bg, int ldb, int K, char* ldsraw,
                      f32x16 (&acc)[2][2]) {
  const int tid = TID(), lane = tid & 63, w = tid >> 6, wm = w >> 1, wn = w & 1, r = lane & 31, h = lane >> 5;
  u16* As = (u16*)ldsraw;
  u16* Bs = As + 2 * 128 * LDT;
  uint4 ra[4], rb[4];
  const int nk = K >> 6;
  const int row0 = tid >> 3, cc = tid & 7;
#pragma unroll
  for (int i = 0; i < 4; ++i) {
    ra[i] = *(const uint4*)(Ag + (size_t)(row0 + 32 * i) * lda + cc * 8);
    rb[i] = *(const uint4*)(Bg + (size_t)(row0 + 32 * i) * ldb + cc * 8);
  }
#pragma unroll
  for (int i = 0; i < 4; ++i) {
    *(uint4*)(As + (row0 + 32 * i) * LDT + cc * 8) = ra[i];
    *(uint4*)(Bs + (row0 + 32 * i) * LDT + cc * 8) = rb[i];
  }
  __syncthreads();
  for (int kt = 0; kt < nk; ++kt) {
    const bool more = (kt + 1 < nk);
    if (more) {
#pragma unroll
      for (int i = 0; i < 4; ++i) {
        ra[i] = *(const uint4*)(Ag + (size_t)(row0 + 32 * i) * lda + (kt + 1) * 64 + cc * 8);
        rb[i] = *(const uint4*)(Bg + (size_t)(row0 + 32 * i) * ldb + (kt + 1) * 64 + cc * 8);
      }
    }
    const u16* a_ = As + (kt & 1) * 128 * LDT + (wm * 64 + r) * LDT + 8 * h;
    const u16* b_ = Bs + (kt & 1) * 128 * LDT + (wn * 64 + r) * LDT + 8 * h;
#pragma unroll
    for (int ks = 0; ks < 4; ++ks) {
      bf16x8 a0 = *(const bf16x8*)(a_ + ks * 16);
      bf16x8 a1 = *(const bf16x8*)(a_ + 32 * LDT + ks * 16);
      bf16x8 b0 = *(const bf16x8*)(b_ + ks * 16);
      bf16x8 b1 = *(const bf16x8*)(b_ + 32 * LDT + ks * 16);
      acc[0][0] = MFMA(b0, a0, acc[0][0]);
      acc[0][1] = MFMA(b1, a0, acc[0][1]);
      acc[1][0] = MFMA(b0, a1, acc[1][0]);
      acc[1][1] = MFMA(b1, a1, acc[1][1]);
    }
    if (more) {
      u16* As2 = As + ((kt + 1) & 1) * 128 * LDT;
      u16* Bs2 = Bs + ((kt + 1) & 1) * 128 * LDT;
#pragma unroll
      for (int i = 0; i < 4; ++i) {
        *(uint4*)(As2 + (row0 + 32 * i) * LDT + cc * 8) = ra[i];
        *(uint4*)(Bs2 + (row0 + 32 * i) * LDT + cc * 8) = rb[i];
      }
    }
    __syncthreads();
  }
}

DI void zero_acc(f32x16 (&acc)[2][2]) {
#pragma unroll
  for (int a = 0; a < 2; ++a)
#pragma unroll
    for (int b = 0; b < 2; ++b)
#pragma unroll
      for (int i = 0; i < 16; ++i) acc[a][b][i] = 0.f;
}

DI int win_srccol(int n) {
  if (n < 1536) return n;
  if (n < 4352) return n + 8;
  if (n < 6400) return n + 32;
  if (n < 6408) return 1536 + (n - 6400);
  if (n < 6432) return 4360 + (n - 6408);
  return -1;
}
DI void transpose_tile(const float* __restrict__ src, int sld, int k0, int n0, int kind, u16* __restrict__ dst, int dld,
                       char* ldsraw) {
  float* t = (float*)ldsraw;
  const int tid = TID();
  {
    const int nn = tid & 63, kq = tid >> 6;
    const int n = n0 + nn;
    const int sc = (kind == 0) ? win_srccol(n) : ((kind == 1) ? 6432 + n : n);
#pragma unroll
    for (int i = 0; i < 16; ++i) {
      const int kk = kq * 16 + i;
      t[kk * 65 + nn] = (sc >= 0) ? src[(size_t)(k0 + kk) * sld + sc] : 0.f;
    }
  }
  __syncthreads();
  {
    const int nn = tid >> 2, ks = (tid & 3) * 16;
    unsigned o[8];
#pragma unroll
    for (int i = 0; i < 8; ++i) o[i] = pk2(t[(ks + 2 * i) * 65 + nn], t[(ks + 2 * i + 1) * 65 + nn]);
    uint4* d = (uint4*)(dst + (size_t)(n0 + nn) * dld + k0 + ks);
    d[0] = make_uint4(o[0], o[1], o[2], o[3]);
    d[1] = make_uint4(o[4], o[5], o[6], o[7]);
  }
  __syncthreads();
}

DI void phase0(const Params& p, int l, const float* __restrict__ xin, char* lds) {
  const int NI = 1632 + 1024 + 512 + 256 + 256;
  for (int it = blockIdx.x; it < NI; it += gridDim.x) {
    if (it < 1632) {
      transpose_tile(p.w_in + (size_t)l * 1024 * 10528, 10528, (it & 15) * 64, (it >> 4) * 64, 0, p.WinT, 1024, lds);
    } else if (it < 2656) {
      const int j = it - 1632;
      transpose_tile(p.w_in + (size_t)l * 1024 * 10528, 10528, (j & 15) * 64, (j >> 4) * 64, 1, p.WgT, 1024, lds);
    } else if (it < 3168) {
      const int j = it - 2656;
      const int n = j >> 7;
      transpose_tile(p.w_branch + ((size_t)(l * 4 + n) * 512) * 1024, 1024, (j & 7) * 64, ((j >> 3) & 15) * 64, 2,
                     p.WbT + (size_t)n * 1024 * 512, 512, lds);
    } else if (it < 3424) {
      const int j = it - 3168;
      transpose_tile(p.w_out + (size_t)l * 1024 * 1024, 1024, (j & 15) * 64, (j >> 4) * 64, 2, p.WoT, 1024, lds);
    } else {
      const int j = it - 3424;
      const int lane = TID() & 63, w = TID() >> 6;
      const float* g = p.norm_g + l * 1024;
      for (int i = 0; i < 16; ++i) {
        const int tok = j * 64 + w * 16 + i;
        const float* xr = xin + (size_t)tok * 1024;
        float4 v[4];
        float ss = 0.f;
#pragma unroll
        for (int q = 0; q < 4; ++q) {
          v[q] = *(const float4*)(xr + lane * 4 + 256 * q);
          ss += v[q].x * v[q].x + v[q].y * v[q].y + v[q].z * v[q].z + v[q].w * v[q].w;
        }
        ss = wave_sum(ss);
        const float rs = rsqrtf(ss * (1.f / 1024.f) + 1e-6f);
#pragma unroll
        for (int q = 0; q < 4; ++q) {
          const float4 gg = *(const float4*)(g + lane * 4 + 256 * q);
          uint2 o;
          o.x = pk2(v[q].x * rs * gg.x, v[q].y * rs * gg.y);
          o.y = pk2(v[q].z * rs * gg.z, v[q].w * rs * gg.w);
          *(uint2*)(p.xn + (size_t)tok * 1024 + lane * 4 + 256 * q) = o;
        }
      }
    }
  }
}

DI void phase1(const Params& p, char* lds) {
  const int tid = TID(), lane = tid & 63, w = tid >> 6, wm = w >> 1, wn = w & 1, r = lane & 31, h = lane >> 5;
  for (int tile = blockIdx.x; tile < 128 * 51; tile += gridDim.x) {
    const int grp = tile / (32 * 51), rem = tile % (32 * 51);
    const int nt = rem >> 5, mt = grp * 32 + (rem & 31);
    f32x16 acc[2][2];
    zero_acc(acc);
    gemm_mainloop(p.xn + (size_t)mt * 128 * 1024, 1024, p.WinT + (size_t)nt * 128 * 1024, 1024, 1024, lds, acc);
#pragma unroll
    for (int mi = 0; mi < 2; ++mi) {
      const size_t row = (size_t)mt * 128 + wm * 64 + mi * 32 + r;
#pragma unroll
      for (int ni = 0; ni < 2; ++ni) {
#pragma unroll
        for (int a = 0; a < 4; ++a) {
          const int col = nt * 128 + wn * 64 + ni * 32 + 8 * a + 4 * h;
          uint2 o;
          o.x = pk2(acc[mi][ni][4 * a], acc[mi][ni][4 * a + 1]);
          o.y = pk2(acc[mi][ni][4 * a + 2], acc[mi][ni][4 * a + 3]);
          *(uint2*)(p.z + row * ZS + col) = o;
        }
      }
    }
  }
}

DI void phase4(const Params& p, char* lds) {
  const int tid = TID(), lane = tid & 63, w = tid >> 6, wm = w >> 1, wn = w & 1, r = lane & 31, h = lane >> 5;
  for (int tile = blockIdx.x; tile < 128 * 8; tile += gridDim.x) {
    const int nt = tile & 7, mt = tile >> 3;
    f32x16 mg[2][2];
    zero_acc(mg);
#pragma unroll 1
    for (int n = 0; n < 4; ++n) {
      f32x16 acc[2][2];
      zero_acc(acc);
      gemm_mainloop(p.xn + (size_t)mt * 128 * 1024, 1024, p.WgT + ((size_t)n * 1024 + nt * 128) * 1024, 1024, 1024, lds,
                    acc);
      uint4* scr = p.blkscr + (size_t)blockIdx.x * 8 * 256 + tid;
#pragma unroll
      for (int a = 0; a < 2; ++a)
#pragma unroll
        for (int b = 0; b < 2; ++b)
#pragma unroll
          for (int i = 0; i < 2; ++i) {
            uint4 o;
            o.x = pk2(sigmoidf_(acc[a][b][8 * i]), sigmoidf_(acc[a][b][8 * i + 1]));
            o.y = pk2(sigmoidf_(acc[a][b][8 * i + 2]), sigmoidf_(acc[a][b][8 * i + 3]));
            o.z = pk2(sigmoidf_(acc[a][b][8 * i + 4]), sigmoidf_(acc[a][b][8 * i + 5]));
            o.w = pk2(sigmoidf_(acc[a][b][8 * i + 6]), sigmoidf_(acc[a][b][8 * i + 7]));
            scr[((a * 2 + b) * 2 + i) * 256] = o;
          }
      zero_acc(acc);
      const int yoff = (n == 0) ? GA : ((n == 1) ? GB : ((n == 2) ? GC : GD));
      gemm_mainloop(p.z + (size_t)mt * 128 * ZS + yoff, ZS, p.WbT + ((size_t)n * 1024 + nt * 128) * 512, 512, 512, lds,
                    acc);
#pragma unroll
      for (int a = 0; a < 2; ++a)
#pragma unroll
        for (int b = 0; b < 2; ++b)
#pragma unroll
          for (int i = 0; i < 2; ++i) {
            const uint4 o = scr[((a * 2 + b) * 2 + i) * 256];
            mg[a][b][8 * i] += bflo(o.x) * acc[a][b][8 * i];
            mg[a][b][8 * i + 1] += bfhi(o.x) * acc[a][b][8 * i + 1];
            mg[a][b][8 * i + 2] += bflo(o.y) * acc[a][b][8 * i + 2];
            mg[a][b][8 * i + 3] += bfhi(o.y) * acc[a][b][8 * i + 3];
            mg[a][b][8 * i + 4] += bflo(o.z) * acc[a][b][8 * i + 4];
            mg[a][b][8 * i + 5] += bfhi(o.z) * acc[a][b][8 * i + 5];
            mg[a][b][8 * i + 6] += bflo(o.w) * acc[a][b][8 * i + 6];
            mg[a][b][8 * i + 7] += bfhi(o.w) * acc[a][b][8 * i + 7];
          }
    }
#pragma unroll
    for (int mi = 0; mi < 2; ++mi) {
      const size_t row = (size_t)mt * 128 + wm * 64 + mi * 32 + r;
#pragma unroll
      for (int ni = 0; ni < 2; ++ni)
#pragma unroll
        for (int a = 0; a < 4; ++a) {
          const int col = nt * 128 + wn * 64 + ni * 32 + 8 * a + 4 * h;
          uint2 o;
          o.x = pk2(mg[mi][ni][4 * a], mg[mi][ni][4 * a + 1]);
          o.y = pk2(mg[mi][ni][4 * a + 2], mg[mi][ni][4 * a + 3]);
          *(uint2*)(p.z + row * ZS + col) = o;
        }
    }
  }
}

DI void phase5(const Params& p, const float* xin, float* xout, char* lds) {
  const int tid = TID(), lane = tid & 63, w = tid >> 6, wm = w >> 1, wn = w & 1, r = lane & 31, h = lane >> 5;
  for (int tile = blockIdx.x; tile < 128 * 8; tile += gridDim.x) {
    const int nt = tile & 7, mt = tile >> 3;
    f32x16 acc[2][2];
    zero_acc(acc);
    gemm_mainloop(p.z + (size_t)mt * 128 * ZS, ZS, p.WoT + (size_t)nt * 128 * 1024, 1024, 1024, lds, acc);
#pragma unroll
    for (int mi = 0; mi < 2; ++mi) {
      const size_t row = (size_t)mt * 128 + wm * 64 + mi * 32 + r;
#pragma unroll
      for (int ni = 0; ni < 2; ++ni)
#pragma unroll
        for (int a = 0; a < 4; ++a) {
          const int col = nt * 128 + wn * 64 + ni * 32 + 8 * a + 4 * h;
          float4 xv = *(const float4*)(xin + row * 1024 + col);
          xv.x += acc[mi][ni][4 * a];
          xv.y += acc[mi][ni][4 * a + 1];
          xv.z += acc[mi][ni][4 * a + 2];
          xv.w += acc[mi][ni][4 * a + 3];
          *(float4*)(xout + row * 1024 + col) = xv;
        }
    }
  }
}

DI void compress_item(const Params& p, int l, int item, char* lds) {
  const int kv = item & 1, cg_ = (item >> 1) & 31, b = item >> 6;
  const int c0 = cg_ * 8;
  const int nc = (c0 + 8 <= 255) ? 8 : (255 - c0);
  const int ntok = 16 * (nc - 1) + 32;
  const int tid = TID();
  u16* tok = (u16*)lds;
  float* hid = (float*)(lds + 144 * 128 * 2);
  const u16* zsrc = p.z + ((size_t)b * S_ + 16 * c0) * ZS + (kv ? VCC : KCC);
  for (int id = tid; id < 144 * 16; id += 256) {
    const int row = id >> 4, c = id & 15;
    uint4 v = make_uint4(0, 0, 0, 0);
    if (row < ntok) v = *(const uint4*)(zsrc + (size_t)row * ZS + c * 8);
    *(uint4*)(tok + row * 128 + c * 8) = v;
  }
  __syncthreads();
  const float* w1 = (kv ? p.cmp_v_w1 : p.cmp_k_w1) + (size_t)l * 2048 * 128;
  const float* w2 = (kv ? p.cmp_v_w2 : p.cmp_k_w2) + (size_t)l * 128 * 64;
  const float* pos = p.cmp_pos + l * 2048;
  {
    const int n = tid & 127, g = tid >> 7;
    float acc[8], accp = 0.f;
#pragma unroll
    for (int i = 0; i < 8; ++i) acc[i] = 0.f;
    for (int j = 0; j < 32; ++j) {
#pragma unroll 4
      for (int d = 0; d < 64; d += 2) {
        const float wa = w1[(size_t)(j * 64 + d) * 128 + n];
        const float wb = w1[(size_t)(j * 64 + d + 1) * 128 + n];
        accp += pos[j * 64 + d] * wa + pos[j * 64 + d + 1] * wb;
#pragma unroll
        for (int ci = 0; ci < 8; ++ci) {
          const unsigned u = *(const unsigned*)(tok + (16 * ci + j) * 128 + g * 64 + d);
          acc[ci] += bflo(u) * wa + bfhi(u) * wb;
        }
      }
    }
#pragma unroll
    for (int ci = 0; ci < 8; ++ci) hid[(g * 8 + ci) * 128 + n] = siluf_(acc[ci] + accp);
  }
  __syncthreads();
  {
    const int e = tid & 63, rq = tid >> 6;
    float o[4] = {0.f, 0.f, 0.f, 0.f};
    for (int n = 0; n < 128; ++n) {
      const float wv = w2[n * 64 + e];
#pragma unroll
      for (int i = 0; i < 4; ++i) o[i] += hid[(rq * 4 + i) * 128 + n] * wv;
    }
    const float gk = p.kn_c[l * 64 + e];
#pragma unroll
    for (int i = 0; i < 4; ++i) {
      const int row = rq * 4 + i, g = row >> 3, ci = row & 7;
      float v = o[i];
      if (kv == 0) {
        const float ss = wave_sum(v * v);
        v = v * rsqrtf(ss * (1.f / 64.f) + 1e-6f) * gk;
      }
      if (ci < nc) {
        u16* dst = (kv ? p.vc : p.kc) + ((size_t)(b * 2 + g) * 256 + c0 + ci) * 64 + e;
        *dst = f2bf(v);
      }
    }
    if (cg_ == 31 && tid < 128) {
      u16* dst = (kv ? p.vc : p.kc) + ((size_t)(b * 2 + (tid >> 6)) * 256 + 255) * 64 + (tid & 63);
      *dst = 0;
    }
  }
}

DI void lru_item(const Params& p, int l, int item, int pass, char* lds) {
  const int n = item & 7, chunk = (item >> 3) & 63, b = item >> 9;
  float* xcs = (float*)lds;
  float* segP = xcs + 64 * 64;
  float* segH = segP + 256;
  const int tid = TID(), ch = tid & 63, tq = tid >> 6;
  const int chg = n * 64 + ch;
  const int t0 = chunk * 64 + tq * 16;
  const u16* zb = p.z + (size_t)b * S_ * ZS + XB + chg;
  const float* cw = p.conv_w + l * 4 * 512;
  const float w0 = cw[chg], w1 = cw[512 + chg], w2 = cw[1024 + chg], w3 = cw[1536 + chg];
  const float cb = p.conv_b[l * 512 + chg];
  float xm3 = (t0 >= 3) ? bf2f(zb[(size_t)(t0 - 3) * ZS]) : 0.f;
  float xm2 = (t0 >= 2) ? bf2f(zb[(size_t)(t0 - 2) * ZS]) : 0.f;
  float xm1 = (t0 >= 1) ? bf2f(zb[(size_t)(t0 - 1) * ZS]) : 0.f;
  float xc[16];
#pragma unroll
  for (int i = 0; i < 16; ++i) {
    const float cur = bf2f(zb[(size_t)(t0 + i) * ZS]);
    xc[i] = cb + w0 * xm3 + w1 * xm2 + w2 * xm1 + w3 * cur;
    xm3 = xm2; xm2 = xm1; xm1 = cur;
    xcs[(tq * 16 + i) * 64 + ch] = xc[i];
  }
  __syncthreads();
  float aA[16], aX[16];
#pragma unroll
  for (int i = 0; i < 16; ++i) { aA[i] = 0.f; aX[i] = 0.f; }
  const float* wa = p.w_rg_a + ((size_t)(l * 8 + n) * 64) * 64 + ch;
  const float* wx = p.w_rg_x + ((size_t)(l * 8 + n) * 64) * 64 + ch;
  for (int d = 0; d < 64; d += 4) {
    const float wa0 = wa[d * 64], wa1 = wa[(d + 1) * 64], wa2 = wa[(d + 2) * 64], wa3 = wa[(d + 3) * 64];
    const float wx0 = wx[d * 64], wx1 = wx[(d + 1) * 64], wx2 = wx[(d + 2) * 64], wx3 = wx[(d + 3) * 64];
#pragma unroll
    for (int i = 0; i < 16; ++i) {
      const float4 xv = *(const float4*)(xcs + (tq * 16 + i) * 64 + d);
      aA[i] += xv.x * wa0 + xv.y * wa1 + xv.z * wa2 + xv.w * wa3;
      aX[i] += xv.x * wx0 + xv.y * wx1 + xv.z * wx2 + xv.w * wx3;
    }
  }
  const float ba = p.b_rg_a[l * 512 + chg], bx = p.b_rg_x[l * 512 + chg], lam = p.lru_lambda[l * 512 + chg];
  const float sp = fmaxf(-lam, 0.f) + __logf(1.f + __expf(-fabsf(lam)));
  float P = 1.f, H = 0.f;
#pragma unroll
  for (int i = 0; i < 16; ++i) {
    const float rr = sigmoidf_(aA[i] + ba), ig = sigmoidf_(aX[i] + bx);
    const float la = -8.f * rr * sp;
    const float a = __expf(la);
    const float x2 = 2.f * la;
    const float em = (x2 > -0.1f) ? -x2 * (1.f + x2 * (0.5f + x2 * (0.16666667f + x2 * 0.041666667f))) : 1.f - __expf(x2);
    const float bb = sqrtf(fmaxf(em, 0.f)) * ig * xc[i];
    aA[i] = a; aX[i] = bb;
    H = a * H + bb;
    P *= a;
  }
  segP[tq * 64 + ch] = P;
  segH[tq * 64 + ch] = H;
  __syncthreads();
  if (pass == 1) {
    if (tq == 3) {
      float Pt = 1.f, Ht = 0.f;
#pragma unroll
      for (int s = 0; s < 4; ++s) { Ht = segP[s * 64 + ch] * Ht + segH[s * 64 + ch]; Pt *= segP[s * 64 + ch]; }
      float2 o; o.x = Pt; o.y = Ht;
      *(float2*)(p.lrusum + ((size_t)(b * 64 + chunk) * 512 + chg) * 2) = o;
    }
  } else {
    float hh = 0.f;
    for (int c = 0; c < chunk; ++c) {
      const float2 s = *(const float2*)(p.lrusum + ((size_t)(b * 64 + c) * 512 + chg) * 2);
      hh = s.x * hh + s.y;
    }
    for (int s = 0; s < tq; ++s) hh = segP[s * 64 + ch] * hh + segH[s * 64 + ch];
    u16* zg = p.z + ((size_t)b * S_ + t0) * ZS + GB + chg;
#pragma unroll
    for (int i = 0; i < 16; ++i) {
      hh = aA[i] * hh + aX[i];
      const float gt = bf2f(zg[(size_t)i * ZS]);
      zg[(size_t)i * ZS] = f2bf(hh * siluf_(gt));
    }
  }
}

DI void cumsum_item(const Params& p, int l, int item, char* lds) {
  const int hd = item & 7, b = item >> 3;
  float* part = (float*)lds;
  const int tid = TID();
  const float bfv = p.b_forget[l * 8 + hd];
  const u16* zf = p.z + ((size_t)b * S_ + tid * 16) * ZS + FA + hd;
  float v[16], run = 0.f;
#pragma unroll
  for (int i = 0; i < 16; ++i) {
    const float f = bf2f(zf[(size_t)i * ZS]) + bfv;
    const float ls = fminf(f, 0.f) - __logf(1.f + __expf(-fabsf(f)));
    run += ls;
    v[i] = run;
  }
  part[tid] = run;
  __syncthreads();
  float pre = 0.f;
  for (int i = 0; i < tid; ++i) pre += part[i];
  float* dst = p.cbuf + (size_t)(b * 8 + hd) * S_ + tid * 16;
#pragma unroll
  for (int i = 0; i < 16; ++i) dst[i] = (pre + v[i]) * LOG2E;
}

DI void headnorm_item(const Params& p, int l, int item) {
  const int tid = TID();
  for (int i = 0; i < 7; ++i) {
    const int vid = tid + 256 * i;
    const int tokl = vid / 28, hv = vid % 28;
    const size_t tok = (size_t)item * 64 + tokl;
    int col; const float* g; float sc = 1.f;
    if (hv < 8) { col = QA + hv * 64; g = p.qn_a + l * 64; sc = QSCALE; }
    else if (hv < 16) { col = KA + (hv - 8) * 64; g = p.kn_a + l * 64; }
    else if (hv < 24) { col = QC + (hv - 16) * 64; g = p.qn_c + l * 64; sc = QSCALE; }
    else if (hv < 26) { col = KSC + (hv - 24) * 64; g = p.kn_c + l * 64; }
    else { col = KWC + (hv - 26) * 64; g = p.kn_c + l * 64; }
    uint4* ptr = (uint4*)(p.z + tok * ZS + col);
    uint4 v[8];
    float ss = 0.f;
#pragma unroll
    for (int q = 0; q < 8; ++q) {
      v[q] = ptr[q];
      const unsigned uu[4] = {v[q].x, v[q].y, v[q].z, v[q].w};
#pragma unroll
      for (int e = 0; e < 4; ++e) { const float a = bflo(uu[e]), c = bfhi(uu[e]); ss += a * a + c * c; }
    }
    const float rs = rsqrtf(ss * (1.f / 64.f) + 1e-6f) * sc;
#pragma unroll
    for (int q = 0; q < 8; ++q) {
      const unsigned uu[4] = {v[q].x, v[q].y, v[q].z, v[q].w};
      unsigned oo[4];
#pragma unroll
      for (int e = 0; e < 4; ++e)
        oo[e] = pk2(bflo(uu[e]) * rs * g[q * 8 + 2 * e], bfhi(uu[e]) * rs * g[q * 8 + 2 * e + 1]);
      ptr[q] = make_uint4(oo[0], oo[1], oo[2], oo[3]);
    }
  }
}

DI void sgprep_item(const Params& p, int l, int item) {
  const int lane = TID() & 63, w = TID() >> 6;
  const float* g = p.ln_v_g + l * 512 + lane * 8;
  for (int i = 0; i < 16; ++i) {
    const size_t tok = (size_t)item * 64 + w * 16 + i;
    uint4* ptr = (uint4*)(p.z + tok * ZS + VD + lane * 8);
    const uint4 v = *ptr;
    const unsigned uu[4] = {v.x, v.y, v.z, v.w};
    float f[8];
    float s = 0.f;
#pragma unroll
    for (int e = 0; e < 4; ++e) { f[2 * e] = geluf_(bflo(uu[e])); f[2 * e + 1] = geluf_(bfhi(uu[e])); s += f[2 * e] + f[2 * e + 1]; }
    const float mu = wave_sum(s) * (1.f / 512.f);
    float q = 0.f;
#pragma unroll
    for (int e = 0; e < 8; ++e) { f[e] -= mu; q += f[e] * f[e]; }
    const float rs = rsqrtf(wave_sum(q) * (1.f / 512.f) + 1e-6f);
    unsigned oo[4];
#pragma unroll
    for (int e = 0; e < 4; ++e) oo[e] = pk2(f[2 * e] * rs * g[2 * e], f[2 * e + 1] * rs * g[2 * e + 1]);
    *ptr = make_uint4(oo[0], oo[1], oo[2], oo[3]);
  }
}

DI void sg_item(const Params& p, int l, int item, char* lds) {
  const int g = item & 7, chunk = (item >> 3) & 31, b = item >> 8;
  float* vn = (float*)lds;
  const int tid = TID();
  const size_t tokbase = (size_t)b * S_ + chunk * 128;
#pragma unroll
  for (int i = 0; i < 4; ++i) {
    const int id = tid + 256 * i, row = id >> 3, c = id & 7;
    const uint4 v = *(const uint4*)(p.z + (tokbase + row) * ZS + VD + g * 64 + c * 8);
    float* d = vn + row * 64 + c * 8;
    d[0] = bflo(v.x); d[1] = bfhi(v.x); d[2] = bflo(v.y); d[3] = bfhi(v.y);
    d[4] = bflo(v.z); d[5] = bfhi(v.z); d[6] = bflo(v.w); d[7] = bfhi(v.w);
  }
  __syncthreads();
  const int d = tid & 63;
  const int tq = __builtin_amdgcn_readfirstlane(tid >> 6);
  const float* Wg = p.w_spatial + ((size_t)(l * 8 + g) * 128) * 128;
  const float* bs = p.b_spatial + (l * 8 + g) * 128;
  for (int i = 0; i < 32; ++i) {
    const int t = tq + 4 * i;
    const float* wr = Wg + t * 128;
    float acc = 0.f;
    for (int s = 0; s <= t; s += 4) {
      const float4 wv = *(const float4*)(wr + s);
      acc += wv.x * vn[s * 64 + d];
      if (s + 1 <= t) acc += wv.y * vn[(s + 1) * 64 + d];
      if (s + 2 <= t) acc += wv.z * vn[(s + 2) * 64 + d];
      if (s + 3 <= t) acc += wv.w * vn[(s + 3) * 64 + d];
    }
    const float mixed = acc + bs[t];
    u16* zr = p.z + (tokbase + t) * ZS;
    const float u = bf2f(zr[UD + g * 64 + d]);
    const float gd = bf2f(zr[GD + g * 64 + d]);
    zr[GD + g * 64 + d] = f2bf(geluf_(u) * mixed * siluf_(gd));
  }
}

#define LDK 72
#define OFF_CK 36864
#define OFF_IMP 37376
#define OFF_SEL (OFF_IMP + 64 * 65 * 4)
#define OFF_WUNI (OFF_SEL + 512)
#define OFF_TL (OFF_WUNI + 64)
enum { M_FOX = 0, M_CMP = 1, M_CMP2 = 2, M_SLC = 3, M_WIN = 4 };

template <int MODE>
DI void attn_run(char* lds, const u16* __restrict__ Kg, const u16* __restrict__ Vg, int kstride,
                 const float* __restrict__ cgl, int nt, int first_tile, const bf16x8 (&qf)[2][4], f32x16 (&O)[2][2],
                 float (&m)[2], float (&l)[2], const int (&qpos)[2], const float (&cq)[2], const u64 (&selb)[2],
                 const float (&linv)[2], int wq0) {
  const int tid = TID(), lane = tid & 63, w = tid >> 6, r = lane & 31, h = lane >> 5;
  u16* Ks = (u16*)lds;
  u16* Vs = Ks + 2 * 64 * LDK;
  float* cks = (float*)(lds + OFF_CK);
  float* imp = (float*)(lds + OFF_IMP);
  const int* tlist = (const int*)(lds + OFF_TL);
  uint4 rk0, rk1, rv0 = make_uint4(0, 0, 0, 0), rv1 = make_uint4(0, 0, 0, 0);
  float rc = 0.f;
  const int lrow = tid >> 3, lcc = tid & 7;
  const int q4 = (lane & 15) >> 2, p4 = lane & 3, blk = (lane >> 4) & 1;

#define KEY0_OF(i_) ((MODE == M_SLC) ? tlist[(i_)] * 64 : (first_tile + (i_)) * 64)
#define ALOAD(i_)                                                                               \
  {                                                                                             \
    const int k0_ = KEY0_OF(i_);                                                                \
    rk0 = *(const uint4*)(Kg + (size_t)(k0_ + lrow) * kstride + lcc * 8);                       \
    rk1 = *(const uint4*)(Kg + (size_t)(k0_ + lrow + 32) * kstride + lcc * 8);                  \
    if (MODE != M_CMP2) {                                                                       \
      rv0 = *(const uint4*)(Vg + (size_t)(k0_ + lrow) * kstride + lcc * 8);                     \
      rv1 = *(const uint4*)(Vg + (size_t)(k0_ + lrow + 32) * kstride + lcc * 8);                \
    }                                                                                           \
    if (MODE == M_FOX && tid < 64) rc = cgl[k0_ + tid];                                         \
  }
#define ASTORE(b_)                                                                              \
  {                                                                                             \
    *(uint4*)(Ks + (b_) * 64 * LDK + lrow * LDK + lcc * 8) = rk0;                               \
    *(uint4*)(Ks + (b_) * 64 * LDK + (lrow + 32) * LDK + lcc * 8) = rk1;                        \
    if (MODE != M_CMP2) {                                                                       \
      *(uint4*)(Vs + (b_) * 64 * LDK + lrow * LDK + lcc * 8) = rv0;                             \
      *(uint4*)(Vs + (b_) * 64 * LDK + (lrow + 32) * LDK + lcc * 8) = rv1;                      \
    }                                                                                           \
    if (MODE == M_FOX && tid < 64) cks[(b_) * 64 + tid] = rc;                                   \
  }

  ALOAD(0);
  ASTORE(0);
  __syncthreads();
  for (int it = 0; it < nt; ++it) {
    if (it + 1 < nt) ALOAD(it + 1);
    const int key0 = KEY0_OF(it);
    const u16* Kt = Ks + (it & 1) * 64 * LDK;
    const u16* Vt = Vs + (it & 1) * 64 * LDK;
    const float* ckt = cks + (it & 1) * 64;
#pragma unroll
    for (int kb = 0; kb < 2; ++kb) {
      const int kbase = key0 + kb * 32;
      bool need = true;
      if (MODE == M_FOX || MODE == M_SLC) need = (kbase <= wq0 + 63);
      if (MODE == M_WIN) need = (kbase <= wq0 + 63) && (kbase + 31 > wq0 - 512);
      if (MODE == M_CMP) need = (16 * kbase + 31 <= wq0 + 63);
      float mainv[2][4], spill[2][4];
      if (need) {
        f32x16 S[2];
#pragma unroll
        for (int i = 0; i < 16; ++i) { S[0][i] = 0.f; S[1][i] = 0.f; }
#pragma unroll
        for (int ks = 0; ks < 4; ++ks) {
          const bf16x8 a = *(const bf16x8*)(Kt + (kb * 32 + r) * LDK + ks * 16 + 8 * h);
          S[0] = MFMA(a, qf[0][ks], S[0]);
          S[1] = MFMA(a, qf[1][ks], S[1]);
        }
        float ckv[16];
        if (MODE == M_FOX) {
#pragma unroll
          for (int a4 = 0; a4 < 4; ++a4) {
            const float4 c4 = *(const float4*)(ckt + kb * 32 + 8 * a4 + 4 * h);
            ckv[4 * a4] = c4.x; ckv[4 * a4 + 1] = c4.y; ckv[4 * a4 + 2] = c4.z; ckv[4 * a4 + 3] = c4.w;
          }
        }
        bf16x8 pk[2][2];
#pragma unroll
        for (int nb = 0; nb < 2; ++nb) {
          float sv[16];
          const int t = qpos[nb];
#pragma unroll
          for (int i = 0; i < 16; ++i) {
            const int kk = kbase + (i & 3) + 8 * (i >> 2) + 4 * h;
            float s = S[nb][i];
            bool valid;
            if (MODE == M_FOX) { s += cq[nb] - ckv[i]; valid = (kk <= t); }
            else if (MODE == M_CMP || MODE == M_CMP2) valid = (16 * kk + 31 <= t) && (kk < 255);
            else if (MODE == M_SLC) valid = (((selb[nb] >> (key0 >> 6)) & 1ull) != 0ull) && (kk <= t);
            else valid = (kk <= t) && (kk > t - 512);
            sv[i] = valid ? s : NEGBIG;
          }
          if (MODE == M_CMP2) {
#pragma unroll
            for (int a4 = 0; a4 < 4; ++a4) {
              float pe[4];
#pragma unroll
              for (int e = 0; e < 4; ++e)
                pe[e] = (sv[4 * a4 + e] > -5e29f) ? exp2f(sv[4 * a4 + e] - m[nb]) * linv[nb] : 0.f;
              mainv[nb][a4] = pe[0] + pe[1] + pe[2] + 0.5f * pe[3];
              spill[nb][a4] = 0.5f * pe[3];
            }
          } else {
            float mx = sv[0];
#pragma unroll
            for (int i = 1; i < 16; ++i) mx = fmaxf(mx, sv[i]);
            mx = fmaxf(mx, __shfl_xor(mx, 32));
            const float mnew = fmaxf(m[nb], mx);
            const float alpha = exp2f(m[nb] - mnew);
            m[nb] = mnew;
            float ps = 0.f;
#pragma unroll
            for (int i = 0; i < 16; ++i) {
              sv[i] = (sv[i] > -5e29f) ? exp2f(sv[i] - mnew) : 0.f;
              ps += sv[i];
            }
            l[nb] = l[nb] * alpha + ps;
#pragma unroll
            for (int i = 0; i < 16; ++i) { O[0][nb][i] *= alpha; O[1][nb][i] *= alpha; }
#pragma unroll
            for (int s2 = 0; s2 < 2; ++s2) {
              const unsigned u0 = pk2(sv[8 * s2], sv[8 * s2 + 1]), u1 = pk2(sv[8 * s2 + 2], sv[8 * s2 + 3]);
              const unsigned u2 = pk2(sv[8 * s2 + 4], sv[8 * s2 + 5]), u3 = pk2(sv[8 * s2 + 6], sv[8 * s2 + 7]);
              const uint4 uu = make_uint4(u0, u1, u2, u3);
              pk[nb][s2] = __builtin_bit_cast(bf16x8, uu);
            }
          }
        }
        if (MODE != M_CMP2) {
#pragma unroll
          for (int s2 = 0; s2 < 2; ++s2) {
#pragma unroll
            for (int db = 0; db < 2; ++db) {
              const u16* vp = Vt + (kb * 32 + 16 * s2 + 4 * h + q4) * LDK + db * 32 + 16 * blk + 4 * p4;
              const s16x4 lo = __builtin_amdgcn_ds_read_tr16_b64_v4i16((__attribute__((address_space(3))) s16x4*)(vp));
              const s16x4 hi = __builtin_amdgcn_ds_read_tr16_b64_v4i16((__attribute__((address_space(3))) s16x4*)(vp + 8 * LDK));
              const bf16x8 a = __builtin_shufflevector(lo, hi, 0, 1, 2, 3, 4, 5, 6, 7);
              O[db][0] = MFMA(a, pk[0][s2], O[db][0]);
              O[db][1] = MFMA(a, pk[1][s2], O[db][1]);
            }
          }
        }
      }
      if (MODE == M_CMP2) {
        const int jb = (kbase >> 2) + h;
        for (int rr = 0; rr < 4; ++rr) {
          if (w == rr) {
#pragma unroll
            for (int nb = 0; nb < 2; ++nb)
#pragma unroll
              for (int a4 = 0; a4 < 4; ++a4) imp[(nb * 32 + r) * 65 + jb + 2 * a4] += mainv[nb][a4];
#pragma unroll
            for (int nb = 0; nb < 2; ++nb)
#pragma unroll
              for (int a4 = 0; a4 < 4; ++a4) imp[(nb * 32 + r) * 65 + jb + 2 * a4 + 1] += spill[nb][a4];
          }
          __syncthreads();
        }
      }
    }
    if (it + 1 < nt) ASTORE((it + 1) & 1);
    __syncthreads();
  }
#undef KEY0_OF
#undef ALOAD
#undef ASTORE
}

DI void attn_init(f32x16 (&O)[2][2], float (&m)[2], float (&l)[2]) {
#pragma unroll
  for (int a = 0; a < 2; ++a)
#pragma unroll
    for (int b = 0; b < 2; ++b)
#pragma unroll
      for (int i = 0; i < 16; ++i) O[a][b][i] = 0.f;
  m[0] = m[1] = NEGBIG;
  l[0] = l[1] = 0.f;
}

DI void fox_item(const Params& p, int l_, int item, char* lds) {
  const int qb = 15 - (item >> 5), bh = item & 31, b = bh >> 3, hd = bh & 7;
  const int tid = TID(), lane = tid & 63, w = tid >> 6, r = lane & 31, h = lane >> 5;
  const int wq0 = qb * 256 + w * 64;
  const int qpos[2] = {wq0 + r, wq0 + 32 + r};
  u16* zb = p.z + (size_t)b * S_ * ZS;
  bf16x8 qf[2][4];
#pragma unroll
  for (int nb = 0; nb < 2; ++nb)
#pragma unroll
    for (int ks = 0; ks < 4; ++ks)
      qf[nb][ks] = *(const bf16x8*)(zb + (size_t)qpos[nb] * ZS + QA + hd * 64 + ks * 16 + 8 * h);
  const float* cb = p.cbuf + (size_t)(b * 8 + hd) * S_;
  const float cq[2] = {cb[qpos[0]], cb[qpos[1]]};
  f32x16 O[2][2];
  float m[2], l[2];
  attn_init(O, m, l);
  const u64 selb[2] = {0ull, 0ull};
  const float linv[2] = {0.f, 0.f};
  attn_run<M_FOX>(lds, zb + KA + hd * 64, zb + VA + hd * 64, ZS, cb, 4 * (qb + 1), 0, qf, O, m, l, qpos, cq, selb, linv, wq0);
#pragma unroll
  for (int nb = 0; nb < 2; ++nb) {
    const float lt = l[nb] + __shfl_xor(l[nb], 32);
    const float inv = (lt > 0.f) ? 1.f / lt : 0.f;
    u16* zr = zb + (size_t)qpos[nb] * ZS + GA + hd * 64;
#pragma unroll
    for (int db = 0; db < 2; ++db)
#pragma unroll
      for (int a4 = 0; a4 < 4; ++a4) {
        uint2* gp = (uint2*)(zr + db * 32 + 8 * a4 + 4 * h);
        const uint2 gv = *gp;
        uint2 o;
        o.x = pk2(O[db][nb][4 * a4] * inv * siluf_(bflo(gv.x)), O[db][nb][4 * a4 + 1] * inv * siluf_(bfhi(gv.x)));
        o.y = pk2(O[db][nb][4 * a4 + 2] * inv * siluf_(bflo(gv.y)), O[db][nb][4 * a4 + 3] * inv * siluf_(bfhi(gv.y)));
        *gp = o;
      }
  }
}

DI void nsa_item(const Params& p, int l_, int item, char* lds) {
  const int qb = 63 - (item >> 3), bg = item & 7, b = bg >> 1, g = bg & 1;
  const int tid = TID(), lane = tid & 63, w = tid >> 6, r = lane & 31, h = lane >> 5;
  const int head = g * 4 + w;
  float* imp = (float*)(lds + OFF_IMP);
  u64* selm = (u64*)(lds + OFF_SEL);
  u64* wuni = (u64*)(lds + OFF_WUNI);
  int* tlist = (int*)(lds + OFF_TL);
  for (int i = tid; i < 64 * 65; i += 256) imp[i] = 0.f;
  const int wq0 = qb * 64;
  const int qpos[2] = {wq0 + r, wq0 + 32 + r};
  u16* zb = p.z + (size_t)b * S_ * ZS;
  bf16x8 qf[2][4];
#pragma unroll
  for (int nb = 0; nb < 2; ++nb)
#pragma unroll
    for (int ks = 0; ks < 4; ++ks)
      qf[nb][ks] = *(const bf16x8*)(zb + (size_t)qpos[nb] * ZS + QC + head * 64 + ks * 16 + 8 * h);
  uint4* scr = p.blkscr + (size_t)blockIdx.x * 8 * 256 + tid;
#define NSA_GATE(c_, nb_) sigmoidf_(bf2f(zb[(size_t)qpos[nb_] * ZS + GATEC + (c_) * 8 + head]))
  const float cq[2] = {0.f, 0.f};
  u64 selb[2] = {0ull, 0ull};
  float linv[2] = {0.f, 0.f};
  f32x16 O[2][2];
  float m[2], l[2];

  attn_init(O, m, l);
  const u16* kcp = p.kc + (size_t)(b * 2 + g) * 256 * 64;
  const u16* vcp = p.vc + (size_t)(b * 2 + g) * 256 * 64;
  attn_run<M_CMP>(lds, kcp, vcp, 64, nullptr, 4, 0, qf, O, m, l, qpos, cq, selb, linv, wq0);
#pragma unroll
  for (int nb = 0; nb < 2; ++nb) {
    const float lt = l[nb] + __shfl_xor(l[nb], 32);
    linv[nb] = (lt > 0.f) ? 1.f / lt : 0.f;
    const float sc = linv[nb] * NSA_GATE(0, nb);
#pragma unroll
    for (int db = 0; db < 2; ++db)
#pragma unroll
      for (int i = 0; i < 2; ++i) {
        uint4 o;
        o.x = pk2(O[db][nb][8 * i] * sc, O[db][nb][8 * i + 1] * sc);
        o.y = pk2(O[db][nb][8 * i + 2] * sc, O[db][nb][8 * i + 3] * sc);
        o.z = pk2(O[db][nb][8 * i + 4] * sc, O[db][nb][8 * i + 5] * sc);
        o.w = pk2(O[db][nb][8 * i + 6] * sc, O[db][nb][8 * i + 7] * sc);
        scr[((nb * 2 + db) * 2 + i) * 256] = o;
      }
  }
  attn_run<M_CMP2>(lds, kcp, vcp, 64, nullptr, 4, 0, qf, O, m, l, qpos, cq, selb, linv, wq0);
  {
    u64 uni = 0ull;
    const int j = lane;
    const bool valid = (j <= qb);
    const bool forced = (j == 0) || (valid && j > qb - 2);
    for (int qq = 0; qq < 16; ++qq) {
      const int q = 16 * w + qq;
      const float sc = forced ? 1e6f : (valid ? imp[q * 65 + j] : -1.f);
      int rank = 0;
#pragma unroll
      for (int i = 0; i < 64; ++i) {
        const float si = __shfl(sc, i);
        rank += ((si > sc) || (si == sc && i < j)) ? 1 : 0;
      }
      const bool sel = (rank < 16) && (sc >= 0.f);
      const u64 mk = __ballot(sel);
      if (lane == 0) selm[q] = mk;
      uni |= mk;
    }
    if (lane == 0) wuni[w] = uni;
  }
  __syncthreads();
  const u64 U = wuni[0] | wuni[1] | wuni[2] | wuni[3];
  if (w == 0 && ((U >> lane) & 1ull)) tlist[__popcll(U & ((1ull << lane) - 1ull))] = lane;
  const int ntl = __popcll(U);
  selb[0] = selm[r];
  selb[1] = selm[32 + r];
  __syncthreads();
  attn_init(O, m, l);
  attn_run<M_SLC>(lds, zb + KSC + g * 64, zb + VSC + g * 64, ZS, nullptr, ntl, 0, qf, O, m, l, qpos, cq, selb, linv, wq0);
#pragma unroll
  for (int nb = 0; nb < 2; ++nb) {
    const float lt = l[nb] + __shfl_xor(l[nb], 32);
    const float sc = ((lt > 0.f) ? 1.f / lt : 0.f) * NSA_GATE(1, nb);
#pragma unroll
    for (int db = 0; db < 2; ++db)
#pragma unroll
      for (int i = 0; i < 2; ++i) {
        uint4 o = scr[((nb * 2 + db) * 2 + i) * 256];
        o.x = pk2(bflo(o.x) + O[db][nb][8 * i] * sc, bfhi(o.x) + O[db][nb][8 * i + 1] * sc);
        o.y = pk2(bflo(o.y) + O[db][nb][8 * i + 2] * sc, bfhi(o.y) + O[db][nb][8 * i + 3] * sc);
        o.z = pk2(bflo(o.z) + O[db][nb][8 * i + 4] * sc, bfhi(o.z) + O[db][nb][8 * i + 5] * sc);
        o.w = pk2(bflo(o.w) + O[db][nb][8 * i + 6] * sc, bfhi(o.w) + O[db][nb][8 * i + 7] * sc);
        scr[((nb * 2 + db) * 2 + i) * 256] = o;
      }
  }
  attn_init(O, m, l);
  const int first = (qb >= 8) ? qb - 8 : 0;
  attn_run<M_WIN>(lds, zb + KWC + g * 64, zb + VWC + g * 64, ZS, nullptr, qb - first + 1, first, qf, O, m, l, qpos, cq, selb, linv, wq0);
#pragma unroll
  for (int nb = 0; nb < 2; ++nb) {
    const float lt = l[nb] + __shfl_xor(l[nb], 32);
    const float sc = ((lt > 0.f) ? 1.f / lt : 0.f) * NSA_GATE(2, nb);
    u16* zr = zb + (size_t)qpos[nb] * ZS + GC + head * 64;
#pragma unroll
    for (int db = 0; db < 2; ++db)
#pragma unroll
      for (int a4 = 0; a4 < 4; ++a4) {
        uint2* gp = (uint2*)(zr + db * 32 + 8 * a4 + 4 * h);
        const uint2 gv = *gp;
        const uint2 pv = *((const uint2*)&scr[((nb * 2 + db) * 2 + (a4 >> 1)) * 256] + (a4 & 1));
        const unsigned o0 = pv.x, o1 = pv.y;
        uint2 o;
        o.x = pk2((bflo(o0) + O[db][nb][4 * a4] * sc) * siluf_(bflo(gv.x)),
                  (bfhi(o0) + O[db][nb][4 * a4 + 1] * sc) * siluf_(bfhi(gv.x)));
        o.y = pk2((bflo(o1) + O[db][nb][4 * a4 + 2] * sc) * siluf_(bflo(gv.y)),
                  (bfhi(o1) + O[db][nb][4 * a4 + 3] * sc) * siluf_(bfhi(gv.y)));
        *gp = o;
      }
  }
}

__global__ void __launch_bounds__(256, 2) hybrid_fwd(Params p) {
  cg::grid_group grid = cg::this_grid();
  __shared__ __attribute__((aligned(16))) char lds[LDS_BYTES];
  __shared__ int slot;
  for (int l = 0; l < 2; ++l) {
    const float* xin = (l == 0) ? p.x : p.out;
    phase0(p, l, xin, lds);
    grid.sync();
    phase1(p, lds);
    grid.sync();
    {
      int* ctr = p.ctr + l * 2;
      for (;;) {
        const int it = pop_item(ctr, &slot);
        if (it >= 2848) break;
        if (it < 256) compress_item(p, l, it, lds);
        else if (it < 2304) lru_item(p, l, it - 256, 1, lds);
        else if (it < 2336) cumsum_item(p, l, it - 2304, lds);
        else if (it < 2592) headnorm_item(p, l, it - 2336);
        else sgprep_item(p, l, it - 2592);
      }
    }
    grid.sync();
    {
      int* ctr = p.ctr + l * 2 + 1;
      for (;;) {
        const int it = pop_item(ctr, &slot);
        if (it >= 4096) break;
        if (it < 512) nsa_item(p, l, it, lds);
        else if (it < 1024) fox_item(p, l, it - 512, lds);
        else if (it < 3072) lru_item(p, l, it - 1024, 2, lds);
        else sg_item(p, l, it - 3072, lds);
      }
    }
    grid.sync();
    phase4(p, lds);
    grid.sync();
    phase5(p, xin, p.out, lds);
    if (l == 0) grid.sync();
  }
}

extern "C" void kernel_launch(void* const* d_in, const int* in_sizes, int n_in, void* d_out, int out_size, void* d_ws,
                              size_t ws_size, hipStream_t stream) {
  static int grid_blocks = 0;
  if (!grid_blocks) {
    int dev = 0, cus = 0, per_cu = 0;
    hipGetDevice(&dev);
    hipDeviceGetAttribute(&cus, hipDeviceAttributeMultiprocessorCount, dev);
    hipOccupancyMaxActiveBlocksPerMultiprocessor(&per_cu, hybrid_fwd, 256, 0);
    if (per_cu > 2) per_cu = 2;
    if (per_cu < 1) per_cu = 1;
    grid_blocks = cus * per_cu;
  }
  Params p{};
  const float** f = (const float**)&p;
  for (int i = 0; i < 25; ++i) f[i] = (const float*)d_in[i];
  p.out = (float*)d_out;
  char* ws = (char*)d_ws;
  size_t off = 0;
  auto take = [&](size_t bytes) { char* r = ws + off; off += (bytes + 255) & ~(size_t)255; return r; };
  p.ctr = (int*)take(256);
  p.z = (u16*)take((size_t)T_ * ZS * 2);
  p.xn = (u16*)take((size_t)T_ * 1024 * 2);
  p.WinT = (u16*)take((size_t)6528 * 1024 * 2);
  p.WgT = (u16*)take((size_t)4096 * 1024 * 2);
  p.WbT = (u16*)take((size_t)4 * 1024 * 512 * 2);
  p.WoT = (u16*)take((size_t)1024 * 1024 * 2);
  p.cbuf = (float*)take((size_t)4 * 8 * S_ * 4);
  p.lrusum = (float*)take((size_t)4 * 64 * 512 * 2 * 4);
  p.kc = (u16*)take((size_t)4 * 2 * 256 * 64 * 2);
  p.vc = (u16*)take((size_t)4 * 2 * 256 * 64 * 2);
  p.blkscr = (uint4*)take((size_t)grid_blocks * 8 * 256 * 16);
  hipMemsetAsync(p.ctr, 0, 256, stream);
  void* args[] = {&p};
  hipError_t e = hipLaunchCooperativeKernel((void*)hybrid_fwd, dim3(grid_blocks), dim3(256), args, 0, stream);
  if (e != hipSuccess) fprintf(stderr, "cooperative launch failed: %s (grid %d)\n", hipGetErrorString(e), grid_blocks);
}
```

```cpp
#include <hip/hip_runtime.h>
#include <hip/hip_cooperative_groups.h>
#include <cstdio>
namespace cg = cooperative_groups;

typedef unsigned short u16;
typedef unsigned long long u64;
typedef short bf16x8 __attribute__((ext_vector_type(8)));
typedef short s16x4 __attribute__((ext_vector_type(4)));
typedef float f32x16 __attribute__((ext_vector_type(16)));
typedef __bf16 bf2_t __attribute__((ext_vector_type(2)));
typedef float f2_t __attribute__((ext_vector_type(2)));

#define DI __device__ __forceinline__
#define MFMA(a, b, c) __builtin_amdgcn_mfma_f32_32x32x16_bf16((a), (b), (c), 0, 0, 0)

#define S_ 4096
#define T_ 16384
#define ZS 6528
#define QA 0
#define KA 512
#define VA 1024
#define GA 1536
#define XB 2048
#define GB 2560
#define QC 3072
#define KCC 3584
#define VCC 3712
#define KSC 3840
#define VSC 3968
#define KWC 4096
#define VWC 4224
#define GC 4352
#define UD 4864
#define VD 5376
#define GD 5888
#define FA 6400
#define GATEC 6408
#define LOG2E 1.4426950408889634f
#define QSCALE (0.125f * LOG2E)
#define NEGBIG (-1e30f)
#define LDS_BYTES 73728
#ifndef REP_P0
#define REP_P0 1
#endif
#ifndef REP_P1
#define REP_P1 1
#endif
#ifndef REP_P2
#define REP_P2 1
#endif
#ifndef P2_MASK
#define P2_MASK 31
#endif
#ifndef REP_P5
#define REP_P5 1
#endif
#ifndef REP_P3
#define REP_P3 1
#endif
#ifndef P3_MASK
#define P3_MASK 15
#endif
#ifndef REP_P4
#define REP_P4 1
#endif

struct Params {
  const float *x, *norm_g, *w_in, *b_forget, *qn_a, *kn_a, *conv_w, *conv_b, *w_rg_a, *b_rg_a, *w_rg_x, *b_rg_x,
      *lru_lambda, *qn_c, *kn_c, *cmp_pos, *cmp_k_w1, *cmp_k_w2, *cmp_v_w1, *cmp_v_w2, *ln_v_g, *w_spatial,
      *b_spatial, *w_branch, *w_out;
  float* out;
  int* ctr;
  u16 *z, *xn, *WinT, *WgT, *WbT, *WoT;
  float *cbuf, *lrusum;
  u16 *kc, *vc;
  uint4* blkscr;
  u16* W1T;
  float* pospart;
  unsigned* bar;
};

DI unsigned pk2(float a, float b) { f2_t v = {a, b}; bf2_t r = __builtin_convertvector(v, bf2_t); return __builtin_bit_cast(unsigned, r); }
DI float bflo(unsigned u) { return __uint_as_float(u << 16); }
DI float bfhi(unsigned u) { return __uint_as_float(u & 0xffff0000u); }
DI float bf2f(u16 v) { return __uint_as_float(((unsigned)v) << 16); }
DI u16 f2bf(float x) { return (u16)(pk2(x, 0.f) & 0xffffu); }
DI float sigmoidf_(float x) { return 1.f / (1.f + __expf(-x)); }
DI float siluf_(float x) { return x / (1.f + __expf(-x)); }
DI float geluf_(float x) { return 0.5f * x * (1.f + erff(x * 0.70710678118654752f)); }
DI float wave_sum(float v) {
#pragma unroll
  for (int o = 32; o > 0; o >>= 1) v += __shfl_xor(v, o);
  return v;
}
DI int TID() { int t = threadIdx.x; asm volatile("" : "+v"(t)); return t; }
DI int pop_item(int* ctr, int* slot) {
  __syncthreads();
  if (threadIdx.x == 0) *slot = atomicAdd(ctr, 1);
  __syncthreads();
  return *slot;
}

#define LDT 72
DI void gemm_mainloop(const u16* __restrict__ Ag, int lda, const u16* __restrict__ Bg, int ldb, int K, char* ldsraw,
                      f32x16 (&acc)[2][2], int akstep = 64) {
  const int tid = TID(), lane = tid & 63, w = tid >> 6, wm = w >> 1, wn = w & 1, r = lane & 31, h = lane >> 5;
  u16* As = (u16*)ldsraw;
  u16* Bs = As + 2 * 128 * LDT;
  uint4 ra[4], rb[4];
  const int nk = K >> 6;
  const int row0 = tid >> 3, cc = tid & 7;
#pragma unroll
  for (int i = 0; i < 4; ++i) {
    ra[i] = *(const uint4*)(Ag + (size_t)(row0 + 32 * i) * lda + cc * 8);
    rb[i] = *(const uint4*)(Bg + (size_t)(row0 + 32 * i) * ldb + cc * 8);
  }
#pragma unroll
  for (int i = 0; i < 4; ++i) {
    *(uint4*)(As + (row0 + 32 * i) * LDT + cc * 8) = ra[i];
    *(uint4*)(Bs + (row0 + 32 * i) * LDT + cc * 8) = rb[i];
  }
  __syncthreads();
  for (int kt = 0; kt < nk; ++kt) {
    const bool more = (kt + 1 < nk);
    if (more) {
#pragma unroll
      for (int i = 0; i < 4; ++i) {
        ra[i] = *(const uint4*)(Ag + (size_t)(row0 + 32 * i) * lda + (size_t)(kt + 1) * akstep + cc * 8);
        rb[i] = *(const uint4*)(Bg + (size_t)(row0 + 32 * i) * ldb + (kt + 1) * 64 + cc * 8);
      }
    }
    const u16* a_ = As + (kt & 1) * 128 * LDT + (wm * 64 + r) * LDT + 8 * h;
    const u16* b_ = Bs + (kt & 1) * 128 * LDT + (wn * 64 + r) * LDT + 8 * h;
#pragma unroll
    for (int ks = 0; ks < 4; ++ks) {
      bf16x8 a0 = *(const bf16x8*)(a_ + ks * 16);
      bf16x8 a1 = *(const bf16x8*)(a_ + 32 * LDT + ks * 16);
      bf16x8 b0 = *(const bf16x8*)(b_ + ks * 16);
      bf16x8 b1 = *(const bf16x8*)(b_ + 32 * LDT + ks * 16);
      acc[0][0] = MFMA(b0, a0, acc[0][0]);
      acc[0][1] = MFMA(b1, a0, acc[0][1]);
      acc[1][0] = MFMA(b0, a1, acc[1][0]);
      acc[1][1] = MFMA(b1, a1, acc[1][1]);
    }
    if (more) {
      u16* As2 = As + ((kt + 1) & 1) * 128 * LDT;
      u16* Bs2 = Bs + ((kt + 1) & 1) * 128 * LDT;
#pragma unroll
      for (int i = 0; i < 4; ++i) {
        *(uint4*)(As2 + (row0 + 32 * i) * LDT + cc * 8) = ra[i];
        *(uint4*)(Bs2 + (row0 + 32 * i) * LDT + cc * 8) = rb[i];
      }
    }
    __syncthreads();
  }
}

DI void zero_acc(f32x16 (&acc)[2][2]) {
#pragma unroll
  for (int a = 0; a < 2; ++a)
#pragma unroll
    for (int b = 0; b < 2; ++b)
#pragma unroll
      for (int i = 0; i < 16; ++i) acc[a][b][i] = 0.f;
}

DI int win_srccol(int n) {
  if (n < 1536) return n;
  if (n < 4352) return n + 8;
  if (n < 6400) return n + 32;
  if (n < 6408) return 1536 + (n - 6400);
  if (n < 6432) return 4360 + (n - 6408);
  return -1;
}
DI void transpose_tile(const float* __restrict__ src, int sld, int k0, int n0, int kind, u16* __restrict__ dst, int dld,
                       char* ldsraw) {
  float* t = (float*)ldsraw;
  const int tid = TID();
  {
    const int nn = tid & 63, kq = tid >> 6;
    const int n = n0 + nn;
    const int sc = (kind == 0) ? win_srccol(n) : ((kind == 1) ? 6432 + n : n);
#pragma unroll
    for (int i = 0; i < 16; ++i) {
      const int kk = kq * 16 + i;
      t[kk * 65 + nn] = (sc >= 0) ? src[(size_t)(k0 + kk) * sld + sc] : 0.f;
    }
  }
  __syncthreads();
  {
    const int nn = tid >> 2, ks = (tid & 3) * 16;
    unsigned o[8];
#pragma unroll
    for (int i = 0; i < 8; ++i) o[i] = pk2(t[(ks + 2 * i) * 65 + nn], t[(ks + 2 * i + 1) * 65 + nn]);
    uint4* d = (uint4*)(dst + (size_t)(n0 + nn) * dld + k0 + ks);
    d[0] = make_uint4(o[0], o[1], o[2], o[3]);
    d[1] = make_uint4(o[4], o[5], o[6], o[7]);
  }
  __syncthreads();
}

DI void phase0(const Params& p, int l, const float* __restrict__ xin, char* lds) {
  const int NI = 1632 + 1024 + 512 + 256 + 256 + 128 + 64;
  for (int it = blockIdx.x; it < NI; it += gridDim.x) {
    if (it < 1632) {
      transpose_tile(p.w_in + (size_t)l * 1024 * 10528, 10528, (it & 15) * 64, (it >> 4) * 64, 0, p.WinT, 1024, lds);
    } else if (it < 2656) {
      const int j = it - 1632;
      transpose_tile(p.w_in + (size_t)l * 1024 * 10528, 10528, (j & 15) * 64, (j >> 4) * 64, 1, p.WgT, 1024, lds);
    } else if (it < 3168) {
      const int j = it - 2656;
      const int n = j >> 7;
      transpose_tile(p.w_branch + ((size_t)(l * 4 + n) * 512) * 1024, 1024, (j & 7) * 64, ((j >> 3) & 15) * 64, 2,
                     p.WbT + (size_t)n * 1024 * 512, 512, lds);
    } else if (it < 3424) {
      const int j = it - 3168;
      transpose_tile(p.w_out + (size_t)l * 1024 * 1024, 1024, (j & 15) * 64, (j >> 4) * 64, 2, p.WoT, 1024, lds);
    } else if (it >= 3808) {
      const int j = it - 3808, kv = j >> 5, kc = j & 31;
      const int tid = TID(), n = tid & 127, kh = tid >> 7;
      const float* w1 = (kv ? p.cmp_v_w1 : p.cmp_k_w1) + (size_t)l * 2048 * 128;
      const float* pos = p.cmp_pos + l * 2048;
      float a = 0.f;
#pragma unroll 8
      for (int k = kc * 64 + kh * 32; k < kc * 64 + kh * 32 + 32; ++k) a += pos[k] * w1[(size_t)k * 128 + n];
      float* tmp = (float*)lds;
      tmp[tid] = a;
      __syncthreads();
      if (tid < 128) p.pospart[(size_t)(kv * 32 + kc) * 128 + tid] = tmp[tid] + tmp[tid + 128];
      __syncthreads();
    } else if (it >= 3680) {
      const int j = it - 3680;
      const int kv = j >> 6;
      transpose_tile((kv ? p.cmp_v_w1 : p.cmp_k_w1) + (size_t)l * 2048 * 128, 128, (j & 31) * 64, ((j >> 5) & 1) * 64, 2,
                     p.W1T + (size_t)kv * 128 * 2048, 2048, lds);
    } else {
      const int j = it - 3424;
      const int lane = TID() & 63, w = TID() >> 6;
      const float* g = p.norm_g + l * 1024;
      for (int i = 0; i < 16; ++i) {
        const int tok = j * 64 + w * 16 + i;
        const float* xr = xin + (size_t)tok * 1024;
        float4 v[4];
        float ss = 0.f;
#pragma unroll
        for (int q = 0; q < 4; ++q) {
          v[q] = *(const float4*)(xr + lane * 4 + 256 * q);
          ss += v[q].x * v[q].x + v[q].y * v[q].y + v[q].z * v[q].z + v[q].w * v[q].w;
        }
        ss = wave_sum(ss);
        const float rs = rsqrtf(ss * (1.f / 1024.f) + 1e-6f);
#pragma unroll
        for (int q = 0; q < 4; ++q) {
          const float4 gg = *(const float4*)(g + lane * 4 + 256 * q);
          uint2 o;
          o.x = pk2(v[q].x * rs * gg.x, v[q].y * rs * gg.y);
          o.y = pk2(v[q].z * rs * gg.z, v[q].w * rs * gg.w);
          *(uint2*)(p.xn + (size_t)tok * 1024 + lane * 4 + 256 * q) = o;
        }
      }
    }
  }
}

DI void phase1(const Params& p, char* lds) {
  const int tid = TID(), lane = tid & 63, w = tid >> 6, wm = w >> 1, wn = w & 1, r = lane & 31, h = lane >> 5;
  for (int tile = blockIdx.x; tile < 128 * 51; tile += gridDim.x) {
    const int grp = tile / (32 * 51), rem = tile % (32 * 51);
    const int nt = rem >> 5, mt = grp * 32 + (rem & 31);
    f32x16 acc[2][2];
    zero_acc(acc);
    gemm_mainloop(p.xn + (size_t)mt * 128 * 1024, 1024, p.WinT + (size_t)nt * 128 * 1024, 1024, 1024, lds, acc);
#pragma unroll
    for (int mi = 0; mi < 2; ++mi) {
      const size_t row = (size_t)mt * 128 + wm * 64 + mi * 32 + r;
#pragma unroll
      for (int ni = 0; ni < 2; ++ni) {
#pragma unroll
        for (int a = 0; a < 4; ++a) {
          const int col = nt * 128 + wn * 64 + ni * 32 + 8 * a + 4 * h;
          uint2 o;
          o.x = pk2(acc[mi][ni][4 * a], acc[mi][ni][4 * a + 1]);
          o.y = pk2(acc[mi][ni][4 * a + 2], acc[mi][ni][4 * a + 3]);
          *(uint2*)(p.z + row * ZS + col) = o;
        }
      }
    }
  }
}

DI void phase4(const Params& p, char* lds) {
  const int tid = TID(), lane = tid & 63, w = tid >> 6, wm = w >> 1, wn = w & 1, r = lane & 31, h = lane >> 5;
  for (int tile = blockIdx.x; tile < 128 * 8; tile += gridDim.x) {
    const int nt = tile & 7, mt = tile >> 3;
    f32x16 mg[2][2];
    zero_acc(mg);
#pragma unroll 1
    for (int n = 0; n < 4; ++n) {
      f32x16 acc[2][2];
      zero_acc(acc);
      gemm_mainloop(p.xn + (size_t)mt * 128 * 1024, 1024, p.WgT + ((size_t)n * 1024 + nt * 128) * 1024, 1024, 1024, lds,
                    acc);
      uint4* scr = p.blkscr + (size_t)blockIdx.x * 8 * 256 + tid;
#pragma unroll
      for (int a = 0; a < 2; ++a)
#pragma unroll
        for (int b = 0; b < 2; ++b)
#pragma unroll
          for (int i = 0; i < 2; ++i) {
            uint4 o;
            o.x = pk2(sigmoidf_(acc[a][b][8 * i]), sigmoidf_(acc[a][b][8 * i + 1]));
            o.y = pk2(sigmoidf_(acc[a][b][8 * i + 2]), sigmoidf_(acc[a][b][8 * i + 3]));
            o.z = pk2(sigmoidf_(acc[a][b][8 * i + 4]), sigmoidf_(acc[a][b][8 * i + 5]));
            o.w = pk2(sigmoidf_(acc[a][b][8 * i + 6]), sigmoidf_(acc[a][b][8 * i + 7]));
            scr[((a * 2 + b) * 2 + i) * 256] = o;
          }
      zero_acc(acc);
      const int yoff = (n == 0) ? GA : ((n == 1) ? GB : ((n == 2) ? GC : GD));
      gemm_mainloop(p.z + (size_t)mt * 128 * ZS + yoff, ZS, p.WbT + ((size_t)n * 1024 + nt * 128) * 512, 512, 512, lds,
                    acc);
#pragma unroll
      for (int a = 0; a < 2; ++a)
#pragma unroll
        for (int b = 0; b < 2; ++b)
#pragma unroll
          for (int i = 0; i < 2; ++i) {
            const uint4 o = scr[((a * 2 + b) * 2 + i) * 256];
            mg[a][b][8 * i] += bflo(o.x) * acc[a][b][8 * i];
            mg[a][b][8 * i + 1] += bfhi(o.x) * acc[a][b][8 * i + 1];
            mg[a][b][8 * i + 2] += bflo(o.y) * acc[a][b][8 * i + 2];
            mg[a][b][8 * i + 3] += bfhi(o.y) * acc[a][b][8 * i + 3];
            mg[a][b][8 * i + 4] += bflo(o.z) * acc[a][b][8 * i + 4];
            mg[a][b][8 * i + 5] += bfhi(o.z) * acc[a][b][8 * i + 5];
            mg[a][b][8 * i + 6] += bflo(o.w) * acc[a][b][8 * i + 6];
            mg[a][b][8 * i + 7] += bfhi(o.w) * acc[a][b][8 * i + 7];
          }
    }
#pragma unroll
    for (int mi = 0; mi < 2; ++mi) {
      const size_t row = (size_t)mt * 128 + wm * 64 + mi * 32 + r;
#pragma unroll
      for (int ni = 0; ni < 2; ++ni)
#pragma unroll
        for (int a = 0; a < 4; ++a) {
          const int col = nt * 128 + wn * 64 + ni * 32 + 8 * a + 4 * h;
          uint2 o;
          o.x = pk2(mg[mi][ni][4 * a], mg[mi][ni][4 * a + 1]);
          o.y = pk2(mg[mi][ni][4 * a + 2], mg[mi][ni][4 * a + 3]);
          *(uint2*)(p.z + row * ZS + col) = o;
        }
    }
  }
}

DI void phase5(const Params& p, const float* xin, float* xout, char* lds) {
  const int tid = TID(), lane = tid & 63, w = tid >> 6, wm = w >> 1, wn = w & 1, r = lane & 31, h = lane >> 5;
  for (int tile = blockIdx.x; tile < 128 * 8; tile += gridDim.x) {
    const int nt = tile & 7, mt = tile >> 3;
    f32x16 acc[2][2];
    zero_acc(acc);
    gemm_mainloop(p.z + (size_t)mt * 128 * ZS, ZS, p.WoT + (size_t)nt * 128 * 1024, 1024, 1024, lds, acc);
#pragma unroll
    for (int mi = 0; mi < 2; ++mi) {
      const size_t row = (size_t)mt * 128 + wm * 64 + mi * 32 + r;
#pragma unroll
      for (int ni = 0; ni < 2; ++ni)
#pragma unroll
        for (int a = 0; a < 4; ++a) {
          const int col = nt * 128 + wn * 64 + ni * 32 + 8 * a + 4 * h;
          float4 xv = *(const float4*)(xin + row * 1024 + col);
          xv.x += acc[mi][ni][4 * a];
          xv.y += acc[mi][ni][4 * a + 1];
          xv.z += acc[mi][ni][4 * a + 2];
          xv.w += acc[mi][ni][4 * a + 3];
          *(float4*)(xout + row * 1024 + col) = xv;
        }
    }
  }
}

DI void compress_item(const Params& p, int l, int item, char* lds) {
  const int kv = item & 1, half = (item >> 1) & 1, g = (item >> 2) & 1, b = item >> 3;
  const int tid = TID(), lane = tid & 63, w = tid >> 6, wm = w >> 1, wn = w & 1, r = lane & 31, h = lane >> 5;
  const float* w2 = (kv ? p.cmp_v_w2 : p.cmp_k_w2) + (size_t)l * 128 * 64;
  float* posw = (float*)lds;
  {
    if (tid < 128) {
      float a = 0.f;
#pragma unroll 8
      for (int kc = 0; kc < 32; ++kc) a += p.pospart[(size_t)(kv * 32 + kc) * 128 + tid];
      posw[tid] = a;
    }
    __syncthreads();
  }
  float pw[2][16];
#pragma unroll
  for (int ni = 0; ni < 2; ++ni)
#pragma unroll
    for (int i = 0; i < 16; ++i) pw[ni][i] = posw[wn * 64 + ni * 32 + (i & 3) + 8 * (i >> 2) + 4 * h];
  __syncthreads();
  f32x16 acc[2][2];
  zero_acc(acc);
  const u16* Ag = p.z + ((size_t)b * S_ + 16 * (half * 128)) * ZS + (kv ? VCC : KCC) + g * 64;
  gemm_mainloop(Ag, 16 * ZS, p.W1T + (size_t)kv * 128 * 2048, 2048, 2048, lds, acc, ZS);
  float* hid = (float*)lds;
#pragma unroll
  for (int mi = 0; mi < 2; ++mi)
#pragma unroll
    for (int ni = 0; ni < 2; ++ni)
#pragma unroll
      for (int i = 0; i < 16; ++i) {
        const int row = wm * 64 + mi * 32 + r, col = wn * 64 + ni * 32 + (i & 3) + 8 * (i >> 2) + 4 * h;
        hid[row * 132 + col] = siluf_(acc[mi][ni][i] + pw[ni][i]);
      }
  __syncthreads();
  {
    const int e = tid & 63, rq = tid >> 6;
    float o[32];
#pragma unroll
    for (int i = 0; i < 32; ++i) o[i] = 0.f;
    for (int n = 0; n < 128; n += 4) {
      const float w0 = w2[n * 64 + e], w1v = w2[(n + 1) * 64 + e], w2v = w2[(n + 2) * 64 + e], w3 = w2[(n + 3) * 64 + e];
#pragma unroll
      for (int i = 0; i < 32; ++i) {
        const float4 hv = *(const float4*)(hid + (rq * 32 + i) * 132 + n);
        o[i] += hv.x * w0 + hv.y * w1v + hv.z * w2v + hv.w * w3;
      }
    }
    const float gk = p.kn_c[l * 64 + e];
#pragma unroll
    for (int i = 0; i < 32; ++i) {
      const int c = half * 128 + rq * 32 + i;
      float v = o[i];
      if (kv == 0) {
        const float ss = wave_sum(v * v);
        v = v * rsqrtf(ss * (1.f / 64.f) + 1e-6f) * gk;
      }
      if (c >= 255) v = 0.f;
      u16* dst = (kv ? p.vc : p.kc) + ((size_t)(b * 2 + g) * 256 + c) * 64 + e;
      *dst = f2bf(v);
    }
  }
}

DI void lru_item(const Params& p, int l, int item, int pass, char* lds, int dry = 0) {
  const int n = item & 7, chunk = (item >> 3) & 63, b = item >> 9;
  float* xcs = (float*)lds;
  float* segP = xcs + 64 * 64;
  float* segH = segP + 256;
  const int tid = TID(), ch = tid & 63, tq = tid >> 6;
  const int chg = n * 64 + ch;
  const int t0 = chunk * 64 + tq * 16;
  const u16* zb = p.z + (size_t)b * S_ * ZS + XB + chg;
  const float* cw = p.conv_w + l * 4 * 512;
  const float w0 = cw[chg], w1 = cw[512 + chg], w2 = cw[1024 + chg], w3 = cw[1536 + chg];
  const float cb = p.conv_b[l * 512 + chg];
  float xm3 = (t0 >= 3) ? bf2f(zb[(size_t)(t0 - 3) * ZS]) : 0.f;
  float xm2 = (t0 >= 2) ? bf2f(zb[(size_t)(t0 - 2) * ZS]) : 0.f;
  float xm1 = (t0 >= 1) ? bf2f(zb[(size_t)(t0 - 1) * ZS]) : 0.f;
  float xc[16];
#pragma unroll
  for (int i = 0; i < 16; ++i) {
    const float cur = bf2f(zb[(size_t)(t0 + i) * ZS]);
    xc[i] = cb + w0 * xm3 + w1 * xm2 + w2 * xm1 + w3 * cur;
    xm3 = xm2; xm2 = xm1; xm1 = cur;
    xcs[(tq * 16 + i) * 64 + ch] = xc[i];
  }
  __syncthreads();
  float aA[16], aX[16];
#pragma unroll
  for (int i = 0; i < 16; ++i) { aA[i] = 0.f; aX[i] = 0.f; }
  const float* wa = p.w_rg_a + ((size_t)(l * 8 + n) * 64) * 64 + ch;
  const float* wx = p.w_rg_x + ((size_t)(l * 8 + n) * 64) * 64 + ch;
  for (int d = 0; d < 64; d += 4) {
    const float wa0 = wa[d * 64], wa1 = wa[(d + 1) * 64], wa2 = wa[(d + 2) * 64], wa3 = wa[(d + 3) * 64];
    const float wx0 = wx[d * 64], wx1 = wx[(d + 1) * 64], wx2 = wx[(d + 2) * 64], wx3 = wx[(d + 3) * 64];
#pragma unroll
    for (int i = 0; i < 16; ++i) {
      const float4 xv = *(const float4*)(xcs + (tq * 16 + i) * 64 + d);
      aA[i] += xv.x * wa0 + xv.y * wa1 + xv.z * wa2 + xv.w * wa3;
      aX[i] += xv.x * wx0 + xv.y * wx1 + xv.z * wx2 + xv.w * wx3;
    }
  }
  const float ba = p.b_rg_a[l * 512 + chg], bx = p.b_rg_x[l * 512 + chg], lam = p.lru_lambda[l * 512 + chg];
  const float sp = fmaxf(-lam, 0.f) + __logf(1.f + __expf(-fabsf(lam)));
  float P = 1.f, H = 0.f;
#pragma unroll
  for (int i = 0; i < 16; ++i) {
    const float rr = sigmoidf_(aA[i] + ba), ig = sigmoidf_(aX[i] + bx);
    const float la = -8.f * rr * sp;
    const float a = __expf(la);
    const float x2 = 2.f * la;
    const float em = (x2 > -0.1f) ? -x2 * (1.f + x2 * (0.5f + x2 * (0.16666667f + x2 * 0.041666667f))) : 1.f - __expf(x2);
    const float bb = sqrtf(fmaxf(em, 0.f)) * ig * xc[i];
    aA[i] = a; aX[i] = bb;
    H = a * H + bb;
    P *= a;
  }
  segP[tq * 64 + ch] = P;
  segH[tq * 64 + ch] = H;
  __syncthreads();
  if (pass == 1) {
    if (tq == 3) {
      float Pt = 1.f, Ht = 0.f;
#pragma unroll
      for (int s = 0; s < 4; ++s) { Ht = segP[s * 64 + ch] * Ht + segH[s * 64 + ch]; Pt *= segP[s * 64 + ch]; }
      float2 o; o.x = Pt; o.y = Ht;
      *(float2*)(p.lrusum + ((size_t)(b * 64 + chunk) * 512 + chg) * 2) = o;
    }
  } else {
    float hh = 0.f;
    for (int c = 0; c < chunk; ++c) {
      const float2 s = *(const float2*)(p.lrusum + ((size_t)(b * 64 + c) * 512 + chg) * 2);
      hh = s.x * hh + s.y;
    }
    for (int s = 0; s < tq; ++s) hh = segP[s * 64 + ch] * hh + segH[s * 64 + ch];
    u16* zg = p.z + ((size_t)b * S_ + t0) * ZS + GB + chg;
#pragma unroll
    for (int i = 0; i < 16; ++i) {
      hh = aA[i] * hh + aX[i];
      const float gt = bf2f(zg[(size_t)i * ZS]);
      u16* dst = dry ? ((u16*)(p.blkscr + (size_t)blockIdx.x * 8 * 256 + tid) + (i & 7)) : (zg + (size_t)i * ZS);
      *dst = f2bf(hh * siluf_(gt));
    }
  }
}

DI void cumsum_item(const Params& p, int l, int item, char* lds) {
  const int hd = item & 7, b = item >> 3;
  float* part = (float*)lds;
  const int tid = TID();
  const float bfv = p.b_forget[l * 8 + hd];
  const u16* zf = p.z + ((size_t)b * S_ + tid * 16) * ZS + FA + hd;
  float v[16], run = 0.f;
#pragma unroll
  for (int i = 0; i < 16; ++i) {
    const float f = bf2f(zf[(size_t)i * ZS]) + bfv;
    const float ls = fminf(f, 0.f) - __logf(1.f + __expf(-fabsf(f)));
    run += ls;
    v[i] = run;
  }
  part[tid] = run;
  __syncthreads();
  float pre = 0.f;
  for (int i = 0; i < tid; ++i) pre += part[i];
  float* dst = p.cbuf + (size_t)(b * 8 + hd) * S_ + tid * 16;
#pragma unroll
  for (int i = 0; i < 16; ++i) dst[i] = (pre + v[i]) * LOG2E;
}

DI void headnorm_item(const Params& p, int l, int item, int dry = 0) {
  const int tid = TID();
  for (int i = 0; i < 7; ++i) {
    const int vid = tid + 256 * i;
    const int tokl = vid / 28, hv = vid % 28;
    const size_t tok = (size_t)item * 64 + tokl;
    int col; const float* g; float sc = 1.f;
    if (hv < 8) { col = QA + hv * 64; g = p.qn_a + l * 64; sc = QSCALE; }
    else if (hv < 16) { col = KA + (hv - 8) * 64; g = p.kn_a + l * 64; }
    else if (hv < 24) { col = QC + (hv - 16) * 64; g = p.qn_c + l * 64; sc = QSCALE; }
    else if (hv < 26) { col = KSC + (hv - 24) * 64; g = p.kn_c + l * 64; }
    else { col = KWC + (hv - 26) * 64; g = p.kn_c + l * 64; }
    uint4* ptr = (uint4*)(p.z + tok * ZS + col);
    uint4 v[8];
    float ss = 0.f;
#pragma unroll
    for (int q = 0; q < 8; ++q) {
      v[q] = ptr[q];
      const unsigned uu[4] = {v[q].x, v[q].y, v[q].z, v[q].w};
#pragma unroll
      for (int e = 0; e < 4; ++e) { const float a = bflo(uu[e]), c = bfhi(uu[e]); ss += a * a + c * c; }
    }
    const float rs = rsqrtf(ss * (1.f / 64.f) + 1e-6f) * sc;
#pragma unroll
    for (int q = 0; q < 8; ++q) {
      const unsigned uu[4] = {v[q].x, v[q].y, v[q].z, v[q].w};
      unsigned oo[4];
#pragma unroll
      for (int e = 0; e < 4; ++e)
        oo[e] = pk2(bflo(uu[e]) * rs * g[q * 8 + 2 * e], bfhi(uu[e]) * rs * g[q * 8 + 2 * e + 1]);
      uint4* dp = dry ? (p.blkscr + (size_t)blockIdx.x * 8 * 256 + tid + (q & 7) * 256) : (ptr + q);
      *dp = make_uint4(oo[0], oo[1], oo[2], oo[3]);
    }
  }
}

DI void sgprep_item(const Params& p, int l, int item, int dry = 0) {
  const int lane = TID() & 63, w = TID() >> 6;
  const float* g = p.ln_v_g + l * 512 + lane * 8;
  for (int i = 0; i < 16; ++i) {
    const size_t tok = (size_t)item * 64 + w * 16 + i;
    uint4* ptr = (uint4*)(p.z + tok * ZS + VD + lane * 8);
    const uint4 v = *ptr;
    const unsigned uu[4] = {v.x, v.y, v.z, v.w};
    float f[8];
    float s = 0.f;
#pragma unroll
    for (int e = 0; e < 4; ++e) { f[2 * e] = geluf_(bflo(uu[e])); f[2 * e + 1] = geluf_(bfhi(uu[e])); s += f[2 * e] + f[2 * e + 1]; }
    const float mu = wave_sum(s) * (1.f / 512.f);
    float q = 0.f;
#pragma unroll
    for (int e = 0; e < 8; ++e) { f[e] -= mu; q += f[e] * f[e]; }
    const float rs = rsqrtf(wave_sum(q) * (1.f / 512.f) + 1e-6f);
    unsigned oo[4];
#pragma unroll
    for (int e = 0; e < 4; ++e) oo[e] = pk2(f[2 * e] * rs * g[2 * e], f[2 * e + 1] * rs * g[2 * e + 1]);
    uint4* dp = dry ? (p.blkscr + (size_t)blockIdx.x * 8 * 256 + TID()) : ptr;
    *dp = make_uint4(oo[0], oo[1], oo[2], oo[3]);
  }
}

DI void sg_item(const Params& p, int l, int item, char* lds, int dry) {
  const int g = item & 7, chunk = (item >> 3) & 31, b = item >> 8;
  float* vn = (float*)lds;
  const int tid = TID();
  const size_t tokbase = (size_t)b * S_ + chunk * 128;
#pragma unroll
  for (int i = 0; i < 4; ++i) {
    const int id = tid + 256 * i, row = id >> 3, c = id & 7;
    const uint4 v = *(const uint4*)(p.z + (tokbase + row) * ZS + VD + g * 64 + c * 8);
    float* d = vn + row * 64 + c * 8;
    d[0] = bflo(v.x); d[1] = bfhi(v.x); d[2] = bflo(v.y); d[3] = bfhi(v.y);
    d[4] = bflo(v.z); d[5] = bfhi(v.z); d[6] = bflo(v.w); d[7] = bfhi(v.w);
  }
  __syncthreads();
  const int d = tid & 63;
  const int tq = __builtin_amdgcn_readfirstlane(tid >> 6);
  const float* Wg = p.w_spatial + ((size_t)(l * 8 + g) * 128) * 128;
  const float* bs = p.b_spatial + (l * 8 + g) * 128;
  for (int i = 0; i < 32; ++i) {
    const int t = tq + 4 * i;
    const float* wr = Wg + t * 128;
    float acc = 0.f;
    for (int s = 0; s <= t; s += 4) {
      const float4 wv = *(const float4*)(wr + s);
      acc += wv.x * vn[s * 64 + d];
      if (s + 1 <= t) acc += wv.y * vn[(s + 1) * 64 + d];
      if (s + 2 <= t) acc += wv.z * vn[(s + 2) * 64 + d];
      if (s + 3 <= t) acc += wv.w * vn[(s + 3) * 64 + d];
    }
    const float mixed = acc + bs[t];
    u16* zr = p.z + (tokbase + t) * ZS;
    const float u = bf2f(zr[UD + g * 64 + d]);
    const float gd = bf2f(zr[GD + g * 64 + d]);
    u16* dst = dry ? ((u16*)(p.blkscr + (size_t)blockIdx.x * 8 * 256 + tid) + (i & 7)) : (zr + GD + g * 64 + d);
    *dst = f2bf(geluf_(u) * mixed * siluf_(gd));
  }
}

#define LDK 72
#define OFF_CK 36864
#define OFF_IMP 37376
#define OFF_SEL (OFF_IMP + 64 * 65 * 4)
#define OFF_WUNI (OFF_SEL + 512)
#define OFF_TL (OFF_WUNI + 64)
enum { M_FOX = 0, M_CMP = 1, M_CMP2 = 2, M_SLC = 3, M_WIN = 4 };

template <int MODE>
DI void attn_run(char* lds, const u16* __restrict__ Kg, const u16* __restrict__ Vg, int kstride,
                 const float* __restrict__ cgl, int nt, int first_tile, const bf16x8 (&qf)[2][4], f32x16 (&O)[2][2],
                 float (&m)[2], float (&l)[2], const int (&qpos)[2], const float (&cq)[2], const u64 (&selb)[2],
                 const float (&linv)[2], int wq0) {
  const int tid = TID(), lane = tid & 63, w = tid >> 6, r = lane & 31, h = lane >> 5;
  u16* Ks = (u16*)lds;
  u16* Vs = Ks + 2 * 64 * LDK;
  float* cks = (float*)(lds + OFF_CK);
  float* imp = (float*)(lds + OFF_IMP);
  const int* tlist = (const int*)(lds + OFF_TL);
  uint4 rk0, rk1, rv0 = make_uint4(0, 0, 0, 0), rv1 = make_uint4(0, 0, 0, 0);
  float rc = 0.f;
  const int lrow = tid >> 3, lcc = tid & 7;
  const int q4 = (lane & 15) >> 2, p4 = lane & 3, blk = (lane >> 4) & 1;

#define KEY0_OF(i_) ((MODE == M_SLC) ? tlist[(i_)] * 64 : (first_tile + (i_)) * 64)
#define ALOAD(i_)                                                                               \
  {                                                                                             \
    const int k0_ = KEY0_OF(i_);                                                                \
    rk0 = *(const uint4*)(Kg + (size_t)(k0_ + lrow) * kstride + lcc * 8);                       \
    rk1 = *(const uint4*)(Kg + (size_t)(k0_ + lrow + 32) * kstride + lcc * 8);                  \
    if (MODE != M_CMP2) {                                                                       \
      rv0 = *(const uint4*)(Vg + (size_t)(k0_ + lrow) * kstride + lcc * 8);                     \
      rv1 = *(const uint4*)(Vg + (size_t)(k0_ + lrow + 32) * kstride + lcc * 8);                \
    }                                                                                           \
    if (MODE == M_FOX && tid < 64) rc = cgl[k0_ + tid];                                         \
  }
#define ASTORE(b_)                                                                              \
  {                                                                                             \
    *(uint4*)(Ks + (b_) * 64 * LDK + lrow * LDK + lcc * 8) = rk0;                               \
    *(uint4*)(Ks + (b_) * 64 * LDK + (lrow + 32) * LDK + lcc * 8) = rk1;                        \
    if (MODE != M_CMP2) {                                                                       \
      *(uint4*)(Vs + (b_) * 64 * LDK + lrow * LDK + lcc * 8) = rv0;                             \
      *(uint4*)(Vs + (b_) * 64 * LDK + (lrow + 32) * LDK + lcc * 8) = rv1;                      \
    }                                                                                           \
    if (MODE == M_FOX && tid < 64) cks[(b_) * 64 + tid] = rc;                                   \
  }

  ALOAD(0);
  ASTORE(0);
  __syncthreads();
  for (int it = 0; it < nt; ++it) {
    if (it + 1 < nt) ALOAD(it + 1);
    const int key0 = KEY0_OF(it);
    const u16* Kt = Ks + (it & 1) * 64 * LDK;
    const u16* Vt = Vs + (it & 1) * 64 * LDK;
    const float* ckt = cks + (it & 1) * 64;
#pragma unroll
    for (int kb = 0; kb < 2; ++kb) {
      const int kbase = key0 + kb * 32;
      bool need = true;
      if (MODE == M_FOX || MODE == M_SLC) need = (kbase <= wq0 + 63);
      if (MODE == M_WIN) need = (kbase <= wq0 + 63) && (kbase + 31 > wq0 - 512);
      if (MODE == M_CMP) need = (16 * kbase + 31 <= wq0 + 63);
      float mainv[2][4], spill[2][4];
      if (need) {
        f32x16 S[2];
#pragma unroll
        for (int i = 0; i < 16; ++i) { S[0][i] = 0.f; S[1][i] = 0.f; }
#pragma unroll
        for (int ks = 0; ks < 4; ++ks) {
          const bf16x8 a = *(const bf16x8*)(Kt + (kb * 32 + r) * LDK + ks * 16 + 8 * h);
          S[0] = MFMA(a, qf[0][ks], S[0]);
          S[1] = MFMA(a, qf[1][ks], S[1]);
        }
        float ckv[16];
        if (MODE == M_FOX) {
#pragma unroll
          for (int a4 = 0; a4 < 4; ++a4) {
            const float4 c4 = *(const float4*)(ckt + kb * 32 + 8 * a4 + 4 * h);
            ckv[4 * a4] = c4.x; ckv[4 * a4 + 1] = c4.y; ckv[4 * a4 + 2] = c4.z; ckv[4 * a4 + 3] = c4.w;
          }
        }
        bf16x8 pk[2][2];
#pragma unroll
        for (int nb = 0; nb < 2; ++nb) {
          float sv[16];
          const int t = qpos[nb];
#pragma unroll
          for (int i = 0; i < 16; ++i) {
            const int kk = kbase + (i & 3) + 8 * (i >> 2) + 4 * h;
            float s = S[nb][i];
            bool valid;
            if (MODE == M_FOX) { s += cq[nb] - ckv[i]; valid = (kk <= t); }
            else if (MODE == M_CMP || MODE == M_CMP2) valid = (16 * kk + 31 <= t) && (kk < 255);
            else if (MODE == M_SLC) valid = (((selb[nb] >> (key0 >> 6)) & 1ull) != 0ull) && (kk <= t);
            else valid = (kk <= t) && (kk > t - 512);
            sv[i] = valid ? s : NEGBIG;
          }
          if (MODE == M_CMP2) {
#pragma unroll
            for (int a4 = 0; a4 < 4; ++a4) {
              float pe[4];
#pragma unroll
              for (int e = 0; e < 4; ++e)
                pe[e] = (sv[4 * a4 + e] > -5e29f) ? exp2f(sv[4 * a4 + e] - m[nb]) * linv[nb] : 0.f;
              mainv[nb][a4] = pe[0] + pe[1] + pe[2] + 0.5f * pe[3];
              spill[nb][a4] = 0.5f * pe[3];
            }
          } else {
            float mx = sv[0];
#pragma unroll
            for (int i = 1; i < 16; ++i) mx = fmaxf(mx, sv[i]);
            mx = fmaxf(mx, __shfl_xor(mx, 32));
            const float mnew = fmaxf(m[nb], mx);
            const float alpha = exp2f(m[nb] - mnew);
            m[nb] = mnew;
            float ps = 0.f;
#pragma unroll
            for (int i = 0; i < 16; ++i) {
              sv[i] = (sv[i] > -5e29f) ? exp2f(sv[i] - mnew) : 0.f;
              ps += sv[i];
            }
            l[nb] = l[nb] * alpha + ps;
#pragma unroll
            for (int i = 0; i < 16; ++i) { O[0][nb][i] *= alpha; O[1][nb][i] *= alpha; }
#pragma unroll
            for (int s2 = 0; s2 < 2; ++s2) {
              const unsigned u0 = pk2(sv[8 * s2], sv[8 * s2 + 1]), u1 = pk2(sv[8 * s2 + 2], sv[8 * s2 + 3]);
              const unsigned u2 = pk2(sv[8 * s2 + 4], sv[8 * s2 + 5]), u3 = pk2(sv[8 * s2 + 6], sv[8 * s2 + 7]);
              const uint4 uu = make_uint4(u0, u1, u2, u3);
              pk[nb][s2] = __builtin_bit_cast(bf16x8, uu);
            }
          }
        }
        if (MODE != M_CMP2) {
#pragma unroll
          for (int s2 = 0; s2 < 2; ++s2) {
#pragma unroll
            for (int db = 0; db < 2; ++db) {
              const u16* vp = Vt + (kb * 32 + 16 * s2 + 4 * h + q4) * LDK + db * 32 + 16 * blk + 4 * p4;
              const s16x4 lo = __builtin_amdgcn_ds_read_tr16_b64_v4i16((__attribute__((address_space(3))) s16x4*)(vp));
              const s16x4 hi = __builtin_amdgcn_ds_read_tr16_b64_v4i16((__attribute__((address_space(3))) s16x4*)(vp + 8 * LDK));
              const bf16x8 a = __builtin_shufflevector(lo, hi, 0, 1, 2, 3, 4, 5, 6, 7);
              O[db][0] = MFMA(a, pk[0][s2], O[db][0]);
              O[db][1] = MFMA(a, pk[1][s2], O[db][1]);
            }
          }
        }
      }
      if (MODE == M_CMP2) {
        const int jb = (kbase >> 2) + h;
        for (int rr = 0; rr < 4; ++rr) {
          if (w == rr) {
#pragma unroll
            for (int nb = 0; nb < 2; ++nb)
#pragma unroll
              for (int a4 = 0; a4 < 4; ++a4) imp[(nb * 32 + r) * 65 + jb + 2 * a4] += mainv[nb][a4];
#pragma unroll
            for (int nb = 0; nb < 2; ++nb)
#pragma unroll
              for (int a4 = 0; a4 < 4; ++a4) imp[(nb * 32 + r) * 65 + jb + 2 * a4 + 1] += spill[nb][a4];
          }
          __syncthreads();
        }
      }
    }
    if (it + 1 < nt) ASTORE((it + 1) & 1);
    __syncthreads();
  }
#undef KEY0_OF
#undef ALOAD
#undef ASTORE
}

DI void attn_init(f32x16 (&O)[2][2], float (&m)[2], float (&l)[2]) {
#pragma unroll
  for (int a = 0; a < 2; ++a)
#pragma unroll
    for (int b = 0; b < 2; ++b)
#pragma unroll
      for (int i = 0; i < 16; ++i) O[a][b][i] = 0.f;
  m[0] = m[1] = NEGBIG;
  l[0] = l[1] = 0.f;
}

DI void fox_item(const Params& p, int l_, int item, char* lds, int dry) {
  const int qb = 15 - (item >> 5), bh = item & 31, b = bh >> 3, hd = bh & 7;
  const int tid = TID(), lane = tid & 63, w = tid >> 6, r = lane & 31, h = lane >> 5;
  const int wq0 = qb * 256 + w * 64;
  const int qpos[2] = {wq0 + r, wq0 + 32 + r};
  u16* zb = p.z + (size_t)b * S_ * ZS;
  bf16x8 qf[2][4];
#pragma unroll
  for (int nb = 0; nb < 2; ++nb)
#pragma unroll
    for (int ks = 0; ks < 4; ++ks)
      qf[nb][ks] = *(const bf16x8*)(zb + (size_t)qpos[nb] * ZS + QA + hd * 64 + ks * 16 + 8 * h);
  const float* cb = p.cbuf + (size_t)(b * 8 + hd) * S_;
  const float cq[2] = {cb[qpos[0]], cb[qpos[1]]};
  f32x16 O[2][2];
  float m[2], l[2];
  attn_init(O, m, l);
  const u64 selb[2] = {0ull, 0ull};
  const float linv[2] = {0.f, 0.f};
  attn_run<M_FOX>(lds, zb + KA + hd * 64, zb + VA + hd * 64, ZS, cb, 4 * (qb + 1), 0, qf, O, m, l, qpos, cq, selb, linv, wq0);
#pragma unroll
  for (int nb = 0; nb < 2; ++nb) {
    const float lt = l[nb] + __shfl_xor(l[nb], 32);
    const float inv = (lt > 0.f) ? 1.f / lt : 0.f;
    u16* zr = zb + (size_t)qpos[nb] * ZS + GA + hd * 64;
#pragma unroll
    for (int db = 0; db < 2; ++db)
#pragma unroll
      for (int a4 = 0; a4 < 4; ++a4) {
        uint2* gp = (uint2*)(zr + db * 32 + 8 * a4 + 4 * h);
        const uint2 gv = *gp;
        uint2 o;
        o.x = pk2(O[db][nb][4 * a4] * inv * siluf_(bflo(gv.x)), O[db][nb][4 * a4 + 1] * inv * siluf_(bfhi(gv.x)));
        o.y = pk2(O[db][nb][4 * a4 + 2] * inv * siluf_(bflo(gv.y)), O[db][nb][4 * a4 + 3] * inv * siluf_(bfhi(gv.y)));
        if (dry) gp = (uint2*)(p.blkscr + (size_t)blockIdx.x * 8 * 256 + tid + ((nb * 8 + db * 4 + a4) >> 1) * 256) + (a4 & 1);
        *gp = o;
      }
  }
}

DI void nsa_item(const Params& p, int l_, int item, char* lds, int dry) {
  const int qb = 63 - (item >> 3), bg = item & 7, b = bg >> 1, g = bg & 1;
  const int tid = TID(), lane = tid & 63, w = tid >> 6, r = lane & 31, h = lane >> 5;
  const int head = g * 4 + w;
  float* imp = (float*)(lds + OFF_IMP);
  u64* selm = (u64*)(lds + OFF_SEL);
  u64* wuni = (u64*)(lds + OFF_WUNI);
  int* tlist = (int*)(lds + OFF_TL);
  for (int i = tid; i < 64 * 65; i += 256) imp[i] = 0.f;
  const int wq0 = qb * 64;
  const int qpos[2] = {wq0 + r, wq0 + 32 + r};
  u16* zb = p.z + (size_t)b * S_ * ZS;
  bf16x8 qf[2][4];
#pragma unroll
  for (int nb = 0; nb < 2; ++nb)
#pragma unroll
    for (int ks = 0; ks < 4; ++ks)
      qf[nb][ks] = *(const bf16x8*)(zb + (size_t)qpos[nb] * ZS + QC + head * 64 + ks * 16 + 8 * h);
  uint4* scr = p.blkscr + (size_t)blockIdx.x * 8 * 256 + tid;
#define NSA_GATE(c_, nb_) sigmoidf_(bf2f(zb[(size_t)qpos[nb_] * ZS + GATEC + (c_) * 8 + head]))
  const float cq[2] = {0.f, 0.f};
  u64 selb[2] = {0ull, 0ull};
  float linv[2] = {0.f, 0.f};
  f32x16 O[2][2];
  float m[2], l[2];

  attn_init(O, m, l);
  const u16* kcp = p.kc + (size_t)(b * 2 + g) * 256 * 64;
  const u16* vcp = p.vc + (size_t)(b * 2 + g) * 256 * 64;
  attn_run<M_CMP>(lds, kcp, vcp, 64, nullptr, 4, 0, qf, O, m, l, qpos, cq, selb, linv, wq0);
#pragma unroll
  for (int nb = 0; nb < 2; ++nb) {
    const float lt = l[nb] + __shfl_xor(l[nb], 32);
    linv[nb] = (lt > 0.f) ? 1.f / lt : 0.f;
    const float sc = linv[nb] * NSA_GATE(0, nb);
#pragma unroll
    for (int db = 0; db < 2; ++db)
#pragma unroll
      for (int i = 0; i < 2; ++i) {
        uint4 o;
        o.x = pk2(O[db][nb][8 * i] * sc, O[db][nb][8 * i + 1] * sc);
        o.y = pk2(O[db][nb][8 * i + 2] * sc, O[db][nb][8 * i + 3] * sc);
        o.z = pk2(O[db][nb][8 * i + 4] * sc, O[db][nb][8 * i + 5] * sc);
        o.w = pk2(O[db][nb][8 * i + 6] * sc, O[db][nb][8 * i + 7] * sc);
        scr[((nb * 2 + db) * 2 + i) * 256] = o;
      }
  }
  attn_run<M_CMP2>(lds, kcp, vcp, 64, nullptr, 4, 0, qf, O, m, l, qpos, cq, selb, linv, wq0);
  {
    u64 uni = 0ull;
    const int j = lane;
    const bool valid = (j <= qb);
    const bool forced = (j == 0) || (valid && j > qb - 2);
    for (int qq = 0; qq < 16; ++qq) {
      const int q = 16 * w + qq;
      const float sc = forced ? 1e6f : (valid ? imp[q * 65 + j] : -1.f);
      int rank = 0;
#pragma unroll
      for (int i = 0; i < 64; ++i) {
        const float si = __shfl(sc, i);
        rank += ((si > sc) || (si == sc && i < j)) ? 1 : 0;
      }
      const bool sel = (rank < 16) && (sc >= 0.f);
      const u64 mk = __ballot(sel);
      if (lane == 0) selm[q] = mk;
      uni |= mk;
    }
    if (lane == 0) wuni[w] = uni;
  }
  __syncthreads();
  const u64 U = wuni[0] | wuni[1] | wuni[2] | wuni[3];
  if (w == 0 && ((U >> lane) & 1ull)) tlist[__popcll(U & ((1ull << lane) - 1ull))] = lane;
  const int ntl = __popcll(U);
  selb[0] = selm[r];
  selb[1] = selm[32 + r];
  __syncthreads();
  attn_init(O, m, l);
  attn_run<M_SLC>(lds, zb + KSC + g * 64, zb + VSC + g * 64, ZS, nullptr, ntl, 0, qf, O, m, l, qpos, cq, selb, linv, wq0);
#pragma unroll
  for (int nb = 0; nb < 2; ++nb) {
    const float lt = l[nb] + __shfl_xor(l[nb], 32);
    const float sc = ((lt > 0.f) ? 1.f / lt : 0.f) * NSA_GATE(1, nb);
#pragma unroll
    for (int db = 0; db < 2; ++db)
#pragma unroll
      for (int i = 0; i < 2; ++i) {
        uint4 o = scr[((nb * 2 + db) * 2 + i) * 256];
        o.x = pk2(bflo(o.x) + O[db][nb][8 * i] * sc, bfhi(o.x) + O[db][nb][8 * i + 1] * sc);
        o.y = pk2(bflo(o.y) + O[db][nb][8 * i + 2] * sc, bfhi(o.y) + O[db][nb][8 * i + 3] * sc);
        o.z = pk2(bflo(o.z) + O[db][nb][8 * i + 4] * sc, bfhi(o.z) + O[db][nb][8 * i + 5] * sc);
        o.w = pk2(bflo(o.w) + O[db][nb][8 * i + 6] * sc, bfhi(o.w) + O[db][nb][8 * i + 7] * sc);
        scr[((nb * 2 + db) * 2 + i) * 256] = o;
      }
  }
  attn_init(O, m, l);
  const int first = (qb >= 8) ? qb - 8 : 0;
  attn_run<M_WIN>(lds, zb + KWC + g * 64, zb + VWC + g * 64, ZS, nullptr, qb - first + 1, first, qf, O, m, l, qpos, cq, selb, linv, wq0);
#pragma unroll
  for (int nb = 0; nb < 2; ++nb) {
    const float lt = l[nb] + __shfl_xor(l[nb], 32);
    const float sc = ((lt > 0.f) ? 1.f / lt : 0.f) * NSA_GATE(2, nb);
    u16* zr = zb + (size_t)qpos[nb] * ZS + GC + head * 64;
#pragma unroll
    for (int db = 0; db < 2; ++db)
#pragma unroll
      for (int a4 = 0; a4 < 4; ++a4) {
        uint2* gp = (uint2*)(zr + db * 32 + 8 * a4 + 4 * h);
        const uint2 gv = *gp;
        const uint2 pv = *((const uint2*)&scr[((nb * 2 + db) * 2 + (a4 >> 1)) * 256] + (a4 & 1));
        const unsigned o0 = pv.x, o1 = pv.y;
        uint2 o;
        o.x = pk2((bflo(o0) + O[db][nb][4 * a4] * sc) * siluf_(bflo(gv.x)),
                  (bfhi(o0) + O[db][nb][4 * a4 + 1] * sc) * siluf_(bfhi(gv.x)));
        o.y = pk2((bflo(o1) + O[db][nb][4 * a4 + 2] * sc) * siluf_(bflo(gv.y)),
                  (bfhi(o1) + O[db][nb][4 * a4 + 3] * sc) * siluf_(bfhi(gv.y)));
        if (dry) gp = (uint2*)&scr[((nb * 2 + db) * 2 + (a4 >> 1)) * 256] + (a4 & 1);
        *gp = o;
      }
  }
}

#define XB_TMO      128
#define XB_XCNT(j)  (256  + 64 * (j))
#define XB_XSUB(j)  (1280 + 64 * (j))
#define XB_XGEN(j)  (2304 + 64 * (j))
#define XB_TOP      3328
#define XB_TOPGEN   3392
#define XCD_BAR_WORDS 3456
#define XB_SPIN_CAP (1u << 18)
#define LAS __attribute__((address_space(3)))

__device__ __forceinline__ unsigned xb_ld(unsigned* p)              { return __hip_atomic_load(p, __ATOMIC_RELAXED, __HIP_MEMORY_SCOPE_AGENT); }
__device__ __forceinline__ unsigned xb_add(unsigned* p, unsigned v) { return __hip_atomic_fetch_add(p, v, __ATOMIC_RELAXED, __HIP_MEMORY_SCOPE_AGENT); }
__device__ __forceinline__ unsigned xb_xcc_id() { return (unsigned)__builtin_amdgcn_s_getreg((3 << 11) | 20) & 0xFu; }
#define XB_SPIN(cond, bar) do { unsigned _sp = 0; while (cond) { __builtin_amdgcn_s_sleep(1); \
    if ((++_sp & 255u) == 0u) { if (xb_ld(&(bar)[XB_TMO])) break; if (_sp > XB_SPIN_CAP) { atomicAdd(&(bar)[XB_TMO], 1u); break; } } } } while (0)

struct XcdBarrier {
    unsigned* bar; unsigned x;
    volatile LAS unsigned* st;
};

__device__ __forceinline__ XcdBarrier xcd_barrier_post(unsigned* bar, volatile LAS unsigned* st) {
    XcdBarrier b; b.bar = bar; b.x = xb_xcc_id(); b.st = st;
    if (threadIdx.x == 0) (void)xb_add(&bar[XB_XCNT(b.x)], 1u);
    return b;
}
__device__ __forceinline__ void xcd_barrier_complete(unsigned* bar, unsigned x, unsigned& nloc, unsigned& nx) {
    const unsigned G = gridDim.x * gridDim.y * gridDim.z;
    unsigned sum, cnt, mine, sp = 0u;
    for (;;) {
        sum = 0u; cnt = 0u; mine = 0u;
#pragma unroll
        for (unsigned j = 0; j < 16; ++j) { const unsigned c = xb_ld(&bar[XB_XCNT(j)]); sum += c; cnt += (c > 0u) ? 1u : 0u; mine = (j == x) ? c : mine; }
        if (sum == G) break;
        __builtin_amdgcn_s_sleep(1);
        if ((++sp & 255u) == 0u) { if (xb_ld(&bar[XB_TMO])) break; if (sp > XB_SPIN_CAP) { atomicAdd(&bar[XB_TMO], 1u); break; } }
    }
    nloc = mine > 0u ? mine : 1u; nx = cnt > 0u ? cnt : 1u;
}

__device__ __forceinline__ void xcd_barrier(const XcdBarrier& b) {
    asm volatile("s_waitcnt vmcnt(0)" ::: "memory");
    __syncthreads();
    if (threadIdx.x == 0) {
        unsigned* bar = b.bar;
        __builtin_amdgcn_s_waitcnt(0);
        unsigned nloc = b.st[0], nx = b.st[1];
        if (nloc == 0u) { xcd_barrier_complete(bar, b.x, nloc, nx); b.st[0] = nloc; b.st[1] = nx; }
        const unsigned old = xb_add(&bar[XB_XSUB(b.x)], 1u);
        const unsigned gen = old / nloc;
        if (old + 1u == (gen + 1u) * nloc) {
            __builtin_amdgcn_fence(__ATOMIC_RELEASE, "agent");
            asm volatile("s_waitcnt vmcnt(0)" ::: "memory");
            const unsigned og = xb_add(&bar[XB_TOP], 1u);
            const unsigned tg = og / nx;
            if (og + 1u == (tg + 1u) * nx) xb_add(&bar[XB_TOPGEN], 1u);
            else XB_SPIN(xb_ld(&bar[XB_TOPGEN]) == tg, bar);
            __builtin_amdgcn_fence(__ATOMIC_ACQUIRE, "agent");
            xb_add(&bar[XB_XGEN(b.x)], 1u);
            asm volatile("s_waitcnt vmcnt(0)" ::: "memory");
        } else {
            XB_SPIN(xb_ld(&bar[XB_XGEN(b.x)]) == gen, bar);
            __builtin_amdgcn_fence(__ATOMIC_ACQUIRE, "agent");
            asm volatile("s_waitcnt vmcnt(0)" ::: "memory");
        }
    }
    __syncthreads();
}


__global__ void __launch_bounds__(256, 2) hybrid_fwd(Params p) {
  cg::grid_group grid = cg::this_grid();
  __shared__ __attribute__((aligned(16))) char lds[LDS_BYTES];
  __shared__ int slot;
  __shared__ uint4 xb_words;
  if (threadIdx.x == 0) xb_words = make_uint4(0u, 0u, 0u, 0u);
  __syncthreads();
  const XcdBarrier xb = xcd_barrier_post(p.bar, (volatile LAS unsigned*)&xb_words);
  for (int l = 0; l < 2; ++l) {
    const float* xin = (l == 0) ? p.x : p.out;
    for (int rep = 0; rep < REP_P0; ++rep) phase0(p, l, xin, lds);
    if (l == 0) grid.sync(); else xcd_barrier(xb);
    for (int rep = 0; rep < REP_P1; ++rep) phase1(p, lds);
    xcd_barrier(xb);
    {
      for (int rep = 0; rep < REP_P2; ++rep) {
        int* ctr = p.ctr + l * 2 + rep * 8;
        const int dry = (rep + 1 < REP_P2) ? 1 : 0;
        for (;;) {
          const int it = pop_item(ctr, &slot);
          if (it >= 2624) break;
          if (it < 32) { if (!dry || (P2_MASK & 1)) compress_item(p, l, it, lds); }
          else if (it < 2080) { if (!dry || (P2_MASK & 2)) lru_item(p, l, it - 32, 1, lds); }
          else if (it < 2112) { if (!dry || (P2_MASK & 4)) cumsum_item(p, l, it - 2080, lds); }
          else if (it < 2368) { if (!dry || (P2_MASK & 8)) headnorm_item(p, l, it - 2112, dry); }
          else { if (!dry || (P2_MASK & 16)) sgprep_item(p, l, it - 2368, dry); }
        }
      }
    }
    xcd_barrier(xb);
    {
      for (int rep = 0; rep < REP_P3; ++rep) {
        int* ctr = p.ctr + l * 2 + 1 + rep * 4;
        const int dry = (rep + 1 < REP_P3) ? 1 : 0;
        for (;;) {
          const int it = pop_item(ctr, &slot);
          if (it >= 4096) break;
          if (it < 512) { if (!dry || (P3_MASK & 1)) nsa_item(p, l, it, lds, dry); }
          else if (it < 1024) { if (!dry || (P3_MASK & 2)) fox_item(p, l, it - 512, lds, dry); }
          else if (it < 3072) { if (!dry || (P3_MASK & 4)) lru_item(p, l, it - 1024, 2, lds, dry); }
          else { if (!dry || (P3_MASK & 8)) sg_item(p, l, it - 3072, lds, dry); }
        }
      }
    }
    xcd_barrier(xb);
    for (int rep = 0; rep < REP_P4; ++rep) phase4(p, lds);
    xcd_barrier(xb);
    for (int rep = 0; rep < ((l == 0) ? REP_P5 : 1); ++rep) phase5(p, xin, p.out, lds);
    if (l == 0) xcd_barrier(xb);
  }
}

extern "C" void kernel_launch(void* const* d_in, const int* in_sizes, int n_in, void* d_out, int out_size, void* d_ws,
                              size_t ws_size, hipStream_t stream) {
  static int grid_blocks = 0;
  if (!grid_blocks) {
    int dev = 0, cus = 0, per_cu = 0;
    hipGetDevice(&dev);
    hipDeviceGetAttribute(&cus, hipDeviceAttributeMultiprocessorCount, dev);
    hipOccupancyMaxActiveBlocksPerMultiprocessor(&per_cu, hybrid_fwd, 256, 0);
    if (per_cu > 2) per_cu = 2;
    if (per_cu < 1) per_cu = 1;
    grid_blocks = cus * per_cu;
  }
  Params p{};
  const float** f = (const float**)&p;
  for (int i = 0; i < 25; ++i) f[i] = (const float*)d_in[i];
  p.out = (float*)d_out;
  char* ws = (char*)d_ws;
  size_t off = 0;
  auto take = [&](size_t bytes) { char* r = ws + off; off += (bytes + 255) & ~(size_t)255; return r; };
  p.ctr = (int*)take(256);
  p.bar = (unsigned*)take((size_t)XCD_BAR_WORDS * 4);
  p.z = (u16*)take((size_t)T_ * ZS * 2);
  p.xn = (u16*)take((size_t)T_ * 1024 * 2);
  p.WinT = (u16*)take((size_t)6528 * 1024 * 2);
  p.WgT = (u16*)take((size_t)4096 * 1024 * 2);
  p.WbT = (u16*)take((size_t)4 * 1024 * 512 * 2);
  p.WoT = (u16*)take((size_t)1024 * 1024 * 2);
  p.cbuf = (float*)take((size_t)4 * 8 * S_ * 4);
  p.lrusum = (float*)take((size_t)4 * 64 * 512 * 2 * 4);
  p.kc = (u16*)take((size_t)4 * 2 * 256 * 64 * 2);
  p.vc = (u16*)take((size_t)4 * 2 * 256 * 64 * 2);
  p.W1T = (u16*)take((size_t)2 * 128 * 2048 * 2);
  p.pospart = (float*)take((size_t)2 * 32 * 128 * 4);
  p.blkscr = (uint4*)take((size_t)grid_blocks * 8 * 256 * 16);
  hipMemsetAsync(p.ctr, 0, 256 + (((size_t)XCD_BAR_WORDS * 4 + 255) & ~(size_t)255), stream);
  void* args[] = {&p};
  hipError_t e = hipLaunchCooperativeKernel((void*)hybrid_fwd, dim3(grid_blocks), dim3(256), args, 0, stream);
  if (e != hipSuccess) fprintf(stderr, "cooperative launch failed: %s (grid %d)\n", hipGetErrorString(e), grid_blocks);
}
```

```cpp
#include <hip/hip_runtime.h>
#include <hip/hip_cooperative_groups.h>
#include <cstdio>
namespace cg = cooperative_groups;

typedef unsigned short u16;
typedef unsigned long long u64;
typedef short bf16x8 __attribute__((ext_vector_type(8)));
typedef short s16x4 __attribute__((ext_vector_type(4)));
typedef float f32x16 __attribute__((ext_vector_type(16)));
typedef __bf16 bf2_t __attribute__((ext_vector_type(2)));
typedef float f2_t __attribute__((ext_vector_type(2)));

#define DI __device__ __forceinline__
#define MFMA(a, b, c) __builtin_amdgcn_mfma_f32_32x32x16_bf16((a), (b), (c), 0, 0, 0)

#define S_ 4096
#define T_ 16384
#define ZS 6528
#define QA 0
#define KA 512
#define VA 1024
#define GA 1536
#define XB 2048
#define GB 2560
#define QC 3072
#define KCC 3584
#define VCC 3712
#define KSC 3840
#define VSC 3968
#define KWC 4096
#define VWC 4224
#define GC 4352
#define UD 4864
#define VD 5376
#define GD 5888
#define FA 6400
#define GATEC 6408
#define LOG2E 1.4426950408889634f
#define QSCALE (0.125f * LOG2E)
#define NEGBIG (-1e30f)
#define LDS_BYTES 73728
#ifndef REP_P0
#define REP_P0 1
#endif
#ifndef REP_P1
#define REP_P1 1
#endif
#ifndef REP_P2
#define REP_P2 1
#endif
#ifndef P2_MASK
#define P2_MASK 31
#endif
#ifndef REP_P5
#define REP_P5 1
#endif
#ifndef REP_P3
#define REP_P3 1
#endif
#ifndef P3_MASK
#define P3_MASK 15
#endif
#ifndef REP_P4
#define REP_P4 1
#endif

struct Params {
  const float *x, *norm_g, *w_in, *b_forget, *qn_a, *kn_a, *conv_w, *conv_b, *w_rg_a, *b_rg_a, *w_rg_x, *b_rg_x,
      *lru_lambda, *qn_c, *kn_c, *cmp_pos, *cmp_k_w1, *cmp_k_w2, *cmp_v_w1, *cmp_v_w2, *ln_v_g, *w_spatial,
      *b_spatial, *w_branch, *w_out;
  float* out;
  int* ctr;
  u16 *z, *xn, *WinT, *WgT, *WbT, *WoT;
  float *cbuf, *lrusum;
  u16 *kc, *vc;
  uint4* blkscr;
  u16* W1T;
  float* pospart;
  unsigned* bar;
};

DI unsigned pk2(float a, float b) { f2_t v = {a, b}; bf2_t r = __builtin_convertvector(v, bf2_t); return __builtin_bit_cast(unsigned, r); }
DI float bflo(unsigned u) { return __uint_as_float(u << 16); }
DI float bfhi(unsigned u) { return __uint_as_float(u & 0xffff0000u); }
DI float bf2f(u16 v) { return __uint_as_float(((unsigned)v) << 16); }
DI u16 f2bf(float x) { return (u16)(pk2(x, 0.f) & 0xffffu); }
DI float sigmoidf_(float x) { return 1.f / (1.f + __expf(-x)); }
DI float siluf_(float x) { return x / (1.f + __expf(-x)); }
DI float geluf_(float x) { return 0.5f * x * (1.f + erff(x * 0.70710678118654752f)); }
DI float wave_sum(float v) {
#pragma unroll
  for (int o = 32; o > 0; o >>= 1) v += __shfl_xor(v, o);
  return v;
}
DI int TID() { int t = threadIdx.x; asm volatile("" : "+v"(t)); return t; }
DI int pop_item(int* ctr, int* slot) {
  __syncthreads();
  if (threadIdx.x == 0) *slot = atomicAdd(ctr, 1);
  __syncthreads();
  return *slot;
}

#define LDT 72
#define GEMM_GL1(P, i_, kt_)                                                                           \
  P##a##i_ = *(const uint4*)(Ag + (size_t)(row0 + 32 * i_) * lda + (size_t)(kt_) * akstep + cc * 8);   \
  P##b##i_ = *(const uint4*)(Bg + (size_t)(row0 + 32 * i_) * ldb + (kt_) * 64 + cc * 8);
#define GEMM_GLOAD(P, kt_) { GEMM_GL1(P, 0, kt_) GEMM_GL1(P, 1, kt_) GEMM_GL1(P, 2, kt_) GEMM_GL1(P, 3, kt_) }
#define GEMM_LS1(P, i_, buf_)                                                                  \
  *(uint4*)(As + (buf_) * 128 * LDT + (row0 + 32 * i_) * LDT + cc * 8) = P##a##i_;              \
  *(uint4*)(Bs + (buf_) * 128 * LDT + (row0 + 32 * i_) * LDT + cc * 8) = P##b##i_;
#define GEMM_LSTORE(P, buf_) { GEMM_LS1(P, 0, buf_) GEMM_LS1(P, 1, buf_) GEMM_LS1(P, 2, buf_) GEMM_LS1(P, 3, buf_) }
#define GEMM_COMPUTE(buf_)                                                                               \
  {                                                                                                      \
    const u16* a_ = As + (buf_) * 128 * LDT + (wm * 64 + r) * LDT + 8 * h;                               \
    const u16* b_ = Bs + (buf_) * 128 * LDT + (wn * 64 + r) * LDT + 8 * h;                               \
    _Pragma("unroll") for (int ks = 0; ks < 4; ++ks) {                                                   \
      const bf16x8 a0 = *(const bf16x8*)(a_ + ks * 16);                                                  \
      const bf16x8 a1 = *(const bf16x8*)(a_ + 32 * LDT + ks * 16);                                       \
      const bf16x8 b0 = *(const bf16x8*)(b_ + ks * 16);                                                  \
      const bf16x8 b1 = *(const bf16x8*)(b_ + 32 * LDT + ks * 16);                                       \
      acc[0][0] = MFMA(b0, a0, acc[0][0]);                                                               \
      acc[0][1] = MFMA(b1, a0, acc[0][1]);                                                               \
      acc[1][0] = MFMA(b0, a1, acc[1][0]);                                                               \
      acc[1][1] = MFMA(b1, a1, acc[1][1]);                                                               \
    }                                                                                                    \
  }
template <bool DEEP>
DI void gemm_mainloop_t(const u16* __restrict__ Ag, int lda, const u16* __restrict__ Bg, int ldb, int K, char* ldsraw,
                        f32x16 (&acc)[2][2], int akstep) {
  const int tid = TID(), lane = tid & 63, w = tid >> 6, wm = w >> 1, wn = w & 1, r = lane & 31, h = lane >> 5;
  u16* As = (u16*)ldsraw;
  u16* Bs = As + 2 * 128 * LDT;
  uint4 xa0, xa1, xa2, xa3, xb0, xb1, xb2, xb3;
  const int nk = K >> 6;
  const int row0 = tid >> 3, cc = tid & 7;
  if (DEEP) {
    uint4 ya0, ya1, ya2, ya3, yb0, yb1, yb2, yb3;
    GEMM_GLOAD(x, 0);
    GEMM_GLOAD(y, 1);
    GEMM_LSTORE(x, 0);
    __syncthreads();
    for (int kt = 0; kt < nk; kt += 2) {
      if (kt + 2 < nk) GEMM_GLOAD(x, kt + 2);
      GEMM_COMPUTE(0);
      GEMM_LSTORE(y, 1);
      __syncthreads();
      if (kt + 3 < nk) GEMM_GLOAD(y, kt + 3);
      GEMM_COMPUTE(1);
      if (kt + 2 < nk) GEMM_LSTORE(x, 0);
      __syncthreads();
    }
  } else {
    GEMM_GLOAD(x, 0);
    GEMM_LSTORE(x, 0);
    __syncthreads();
    for (int kt = 0; kt < nk; kt += 2) {
      GEMM_GLOAD(x, kt + 1);
      GEMM_COMPUTE(0);
      GEMM_LSTORE(x, 1);
      __syncthreads();
      if (kt + 2 < nk) GEMM_GLOAD(x, kt + 2);
      GEMM_COMPUTE(1);
      if (kt + 2 < nk) GEMM_LSTORE(x, 0);
      __syncthreads();
    }
  }
}
DI void gemm_mainloop(const u16* __restrict__ Ag, int lda, const u16* __restrict__ Bg, int ldb, int K, char* ldsraw,
                      f32x16 (&acc)[2][2], int akstep = 64) {
  gemm_mainloop_t<true>(Ag, lda, Bg, ldb, K, ldsraw, acc, akstep);
}
DI void gemm_mainloop_shallow(const u16* __restrict__ Ag, int lda, const u16* __restrict__ Bg, int ldb, int K, char* ldsraw,
                              f32x16 (&acc)[2][2]) {
  gemm_mainloop_t<false>(Ag, lda, Bg, ldb, K, ldsraw, acc, 64);
}

DI void zero_acc(f32x16 (&acc)[2][2]) {
#pragma unroll
  for (int a = 0; a < 2; ++a)
#pragma unroll
    for (int b = 0; b < 2; ++b)
#pragma unroll
      for (int i = 0; i < 16; ++i) acc[a][b][i] = 0.f;
}

DI int win_srccol(int n) {
  if (n < 1536) return n;
  if (n < 4352) return n + 8;
  if (n < 6400) return n + 32;
  if (n < 6408) return 1536 + (n - 6400);
  if (n < 6432) return 4360 + (n - 6408);
  return -1;
}
DI void transpose_tile(const float* __restrict__ src, int sld, int k0, int n0, int kind, u16* __restrict__ dst, int dld,
                       char* ldsraw) {
  float* t = (float*)ldsraw;
  const int tid = TID();
  {
    const int nn = tid & 63, kq = tid >> 6;
    const int n = n0 + nn;
    const int sc = (kind == 0) ? win_srccol(n) : ((kind == 1) ? 6432 + n : n);
#pragma unroll
    for (int i = 0; i < 16; ++i) {
      const int kk = kq * 16 + i;
      t[kk * 65 + nn] = (sc >= 0) ? src[(size_t)(k0 + kk) * sld + sc] : 0.f;
    }
  }
  __syncthreads();
  {
    const int nn = tid >> 2, ks = (tid & 3) * 16;
    unsigned o[8];
#pragma unroll
    for (int i = 0; i < 8; ++i) o[i] = pk2(t[(ks + 2 * i) * 65 + nn], t[(ks + 2 * i + 1) * 65 + nn]);
    uint4* d = (uint4*)(dst + (size_t)(n0 + nn) * dld + k0 + ks);
    d[0] = make_uint4(o[0], o[1], o[2], o[3]);
    d[1] = make_uint4(o[4], o[5], o[6], o[7]);
  }
  __syncthreads();
}

DI void phase0(const Params& p, int l, const float* __restrict__ xin, char* lds) {
  const int NI = 1632 + 1024 + 512 + 256 + 256 + 128 + 64;
  for (int it = blockIdx.x; it < NI; it += gridDim.x) {
    if (it < 1632) {
      transpose_tile(p.w_in + (size_t)l * 1024 * 10528, 10528, (it & 15) * 64, (it >> 4) * 64, 0, p.WinT, 1024, lds);
    } else if (it < 2656) {
      const int j = it - 1632;
      transpose_tile(p.w_in + (size_t)l * 1024 * 10528, 10528, (j & 15) * 64, (j >> 4) * 64, 1, p.WgT, 1024, lds);
    } else if (it < 3168) {
      const int j = it - 2656;
      const int n = j >> 7;
      transpose_tile(p.w_branch + ((size_t)(l * 4 + n) * 512) * 1024, 1024, (j & 7) * 64, ((j >> 3) & 15) * 64, 2,
                     p.WbT + (size_t)n * 1024 * 512, 512, lds);
    } else if (it < 3424) {
      const int j = it - 3168;
      transpose_tile(p.w_out + (size_t)l * 1024 * 1024, 1024, (j & 15) * 64, (j >> 4) * 64, 2, p.WoT, 1024, lds);
    } else if (it >= 3808) {
      const int j = it - 3808, kv = j >> 5, kc = j & 31;
      const int tid = TID(), n = tid & 127, kh = tid >> 7;
      const float* w1 = (kv ? p.cmp_v_w1 : p.cmp_k_w1) + (size_t)l * 2048 * 128;
      const float* pos = p.cmp_pos + l * 2048;
      float a = 0.f;
#pragma unroll 8
      for (int k = kc * 64 + kh * 32; k < kc * 64 + kh * 32 + 32; ++k) a += pos[k] * w1[(size_t)k * 128 + n];
      float* tmp = (float*)lds;
      tmp[tid] = a;
      __syncthreads();
      if (tid < 128) p.pospart[(size_t)(kv * 32 + kc) * 128 + tid] = tmp[tid] + tmp[tid + 128];
      __syncthreads();
    } else if (it >= 3680) {
      const int j = it - 3680;
      const int kv = j >> 6;
      transpose_tile((kv ? p.cmp_v_w1 : p.cmp_k_w1) + (size_t)l * 2048 * 128, 128, (j & 31) * 64, ((j >> 5) & 1) * 64, 2,
                     p.W1T + (size_t)kv * 128 * 2048, 2048, lds);
    } else {
      const int j = it - 3424;
      const int lane = TID() & 63, w = TID() >> 6;
      const float* g = p.norm_g + l * 1024;
      for (int i = 0; i < 16; ++i) {
        const int tok = j * 64 + w * 16 + i;
        const float* xr = xin + (size_t)tok * 1024;
        float4 v[4];
        float ss = 0.f;
#pragma unroll
        for (int q = 0; q < 4; ++q) {
          v[q] = *(const float4*)(xr + lane * 4 + 256 * q);
          ss += v[q].x * v[q].x + v[q].y * v[q].y + v[q].z * v[q].z + v[q].w * v[q].w;
        }
        ss = wave_sum(ss);
        const float rs = rsqrtf(ss * (1.f / 1024.f) + 1e-6f);
#pragma unroll
        for (int q = 0; q < 4; ++q) {
          const float4 gg = *(const float4*)(g + lane * 4 + 256 * q);
          uint2 o;
          o.x = pk2(v[q].x * rs * gg.x, v[q].y * rs * gg.y);
          o.y = pk2(v[q].z * rs * gg.z, v[q].w * rs * gg.w);
          *(uint2*)(p.xn + (size_t)tok * 1024 + lane * 4 + 256 * q) = o;
        }
      }
    }
  }
}

DI void phase1(const Params& p, char* lds) {
  const int tid = TID(), lane = tid & 63, w = tid >> 6, wm = w >> 1, wn = w & 1, r = lane & 31, h = lane >> 5;
  for (int tile = blockIdx.x; tile < 128 * 51; tile += gridDim.x) {
    const int grp = tile / (32 * 51), rem = tile % (32 * 51);
    const int nt = rem >> 5, mt = grp * 32 + (rem & 31);
    f32x16 acc[2][2];
    zero_acc(acc);
    gemm_mainloop(p.xn + (size_t)mt * 128 * 1024, 1024, p.WinT + (size_t)nt * 128 * 1024, 1024, 1024, lds, acc);
#pragma unroll
    for (int mi = 0; mi < 2; ++mi) {
      const size_t row = (size_t)mt * 128 + wm * 64 + mi * 32 + r;
#pragma unroll
      for (int ni = 0; ni < 2; ++ni) {
#pragma unroll
        for (int a = 0; a < 4; ++a) {
          const int col = nt * 128 + wn * 64 + ni * 32 + 8 * a + 4 * h;
          uint2 o;
          o.x = pk2(acc[mi][ni][4 * a], acc[mi][ni][4 * a + 1]);
          o.y = pk2(acc[mi][ni][4 * a + 2], acc[mi][ni][4 * a + 3]);
          *(uint2*)(p.z + row * ZS + col) = o;
        }
      }
    }
  }
}

DI void phase4(const Params& p, char* lds) {
  const int tid = TID(), lane = tid & 63, w = tid >> 6, wm = w >> 1, wn = w & 1, r = lane & 31, h = lane >> 5;
  for (int tile = blockIdx.x; tile < 128 * 8; tile += gridDim.x) {
    const int nt = tile & 7, mt = tile >> 3;
    f32x16 mg[2][2];
    zero_acc(mg);
#pragma unroll 1
    for (int n = 0; n < 4; ++n) {
      f32x16 acc[2][2];
      zero_acc(acc);
      gemm_mainloop_shallow(p.xn + (size_t)mt * 128 * 1024, 1024, p.WgT + ((size_t)n * 1024 + nt * 128) * 1024, 1024, 1024, lds,
                    acc);
      uint4* scr = p.blkscr + (size_t)blockIdx.x * 8 * 256 + tid;
#pragma unroll
      for (int a = 0; a < 2; ++a)
#pragma unroll
        for (int b = 0; b < 2; ++b)
#pragma unroll
          for (int i = 0; i < 2; ++i) {
            uint4 o;
            o.x = pk2(sigmoidf_(acc[a][b][8 * i]), sigmoidf_(acc[a][b][8 * i + 1]));
            o.y = pk2(sigmoidf_(acc[a][b][8 * i + 2]), sigmoidf_(acc[a][b][8 * i + 3]));
            o.z = pk2(sigmoidf_(acc[a][b][8 * i + 4]), sigmoidf_(acc[a][b][8 * i + 5]));
            o.w = pk2(sigmoidf_(acc[a][b][8 * i + 6]), sigmoidf_(acc[a][b][8 * i + 7]));
            scr[((a * 2 + b) * 2 + i) * 256] = o;
          }
      zero_acc(acc);
      const int yoff = (n == 0) ? GA : ((n == 1) ? GB : ((n == 2) ? GC : GD));
      gemm_mainloop_shallow(p.z + (size_t)mt * 128 * ZS + yoff, ZS, p.WbT + ((size_t)n * 1024 + nt * 128) * 512, 512, 512, lds,
                    acc);
#pragma unroll
      for (int a = 0; a < 2; ++a)
#pragma unroll
        for (int b = 0; b < 2; ++b)
#pragma unroll
          for (int i = 0; i < 2; ++i) {
            const uint4 o = scr[((a * 2 + b) * 2 + i) * 256];
            mg[a][b][8 * i] += bflo(o.x) * acc[a][b][8 * i];
            mg[a][b][8 * i + 1] += bfhi(o.x) * acc[a][b][8 * i + 1];
            mg[a][b][8 * i + 2] += bflo(o.y) * acc[a][b][8 * i + 2];
            mg[a][b][8 * i + 3] += bfhi(o.y) * acc[a][b][8 * i + 3];
            mg[a][b][8 * i + 4] += bflo(o.z) * acc[a][b][8 * i + 4];
            mg[a][b][8 * i + 5] += bfhi(o.z) * acc[a][b][8 * i + 5];
            mg[a][b][8 * i + 6] += bflo(o.w) * acc[a][b][8 * i + 6];
            mg[a][b][8 * i + 7] += bfhi(o.w) * acc[a][b][8 * i + 7];
          }
    }
#pragma unroll
    for (int mi = 0; mi < 2; ++mi) {
      const size_t row = (size_t)mt * 128 + wm * 64 + mi * 32 + r;
#pragma unroll
      for (int ni = 0; ni < 2; ++ni)
#pragma unroll
        for (int a = 0; a < 4; ++a) {
          const int col = nt * 128 + wn * 64 + ni * 32 + 8 * a + 4 * h;
          uint2 o;
          o.x = pk2(mg[mi][ni][4 * a], mg[mi][ni][4 * a + 1]);
          o.y = pk2(mg[mi][ni][4 * a + 2], mg[mi][ni][4 * a + 3]);
          *(uint2*)(p.z + row * ZS + col) = o;
        }
    }
  }
}

DI void phase5(const Params& p, const float* xin, float* xout, char* lds) {
  const int tid = TID(), lane = tid & 63, w = tid >> 6, wm = w >> 1, wn = w & 1, r = lane & 31, h = lane >> 5;
  for (int tile = blockIdx.x; tile < 128 * 8; tile += gridDim.x) {
    const int nt = tile & 7, mt = tile >> 3;
    f32x16 acc[2][2];
    zero_acc(acc);
    gemm_mainloop(p.z + (size_t)mt * 128 * ZS, ZS, p.WoT + (size_t)nt * 128 * 1024, 1024, 1024, lds, acc);
#pragma unroll
    for (int mi = 0; mi < 2; ++mi) {
      const size_t row = (size_t)mt * 128 + wm * 64 + mi * 32 + r;
#pragma unroll
      for (int ni = 0; ni < 2; ++ni)
#pragma unroll
        for (int a = 0; a < 4; ++a) {
          const int col = nt * 128 + wn * 64 + ni * 32 + 8 * a + 4 * h;
          float4 xv = *(const float4*)(xin + row * 1024 + col);
          xv.x += acc[mi][ni][4 * a];
          xv.y += acc[mi][ni][4 * a + 1];
          xv.z += acc[mi][ni][4 * a + 2];
          xv.w += acc[mi][ni][4 * a + 3];
          *(float4*)(xout + row * 1024 + col) = xv;
        }
    }
  }
}

DI void compress_item(const Params& p, int l, int item, char* lds) {
  const int kv = item & 1, half = (item >> 1) & 1, g = (item >> 2) & 1, b = item >> 3;
  const int tid = TID(), lane = tid & 63, w = tid >> 6, wm = w >> 1, wn = w & 1, r = lane & 31, h = lane >> 5;
  const float* w2 = (kv ? p.cmp_v_w2 : p.cmp_k_w2) + (size_t)l * 128 * 64;
  float* posw = (float*)lds;
  {
    if (tid < 128) {
      float a = 0.f;
#pragma unroll 8
      for (int kc = 0; kc < 32; ++kc) a += p.pospart[(size_t)(kv * 32 + kc) * 128 + tid];
      posw[tid] = a;
    }
    __syncthreads();
  }
  float pw[2][16];
#pragma unroll
  for (int ni = 0; ni < 2; ++ni)
#pragma unroll
    for (int i = 0; i < 16; ++i) pw[ni][i] = posw[wn * 64 + ni * 32 + (i & 3) + 8 * (i >> 2) + 4 * h];
  __syncthreads();
  f32x16 acc[2][2];
  zero_acc(acc);
  const u16* Ag = p.z + ((size_t)b * S_ + 16 * (half * 128)) * ZS + (kv ? VCC : KCC) + g * 64;
  gemm_mainloop(Ag, 16 * ZS, p.W1T + (size_t)kv * 128 * 2048, 2048, 2048, lds, acc, ZS);
  float* hid = (float*)lds;
#pragma unroll
  for (int mi = 0; mi < 2; ++mi)
#pragma unroll
    for (int ni = 0; ni < 2; ++ni)
#pragma unroll
      for (int i = 0; i < 16; ++i) {
        const int row = wm * 64 + mi * 32 + r, col = wn * 64 + ni * 32 + (i & 3) + 8 * (i >> 2) + 4 * h;
        hid[row * 132 + col] = siluf_(acc[mi][ni][i] + pw[ni][i]);
      }
  __syncthreads();
  {
    const int e = tid & 63, rq = tid >> 6;
    float o[32];
#pragma unroll
    for (int i = 0; i < 32; ++i) o[i] = 0.f;
    for (int n = 0; n < 128; n += 4) {
      const float w0 = w2[n * 64 + e], w1v = w2[(n + 1) * 64 + e], w2v = w2[(n + 2) * 64 + e], w3 = w2[(n + 3) * 64 + e];
#pragma unroll
      for (int i = 0; i < 32; ++i) {
        const float4 hv = *(const float4*)(hid + (rq * 32 + i) * 132 + n);
        o[i] += hv.x * w0 + hv.y * w1v + hv.z * w2v + hv.w * w3;
      }
    }
    const float gk = p.kn_c[l * 64 + e];
#pragma unroll
    for (int i = 0; i < 32; ++i) {
      const int c = half * 128 + rq * 32 + i;
      float v = o[i];
      if (kv == 0) {
        const float ss = wave_sum(v * v);
        v = v * rsqrtf(ss * (1.f / 64.f) + 1e-6f) * gk;
      }
      if (c >= 255) v = 0.f;
      u16* dst = (kv ? p.vc : p.kc) + ((size_t)(b * 2 + g) * 256 + c) * 64 + e;
      *dst = f2bf(v);
    }
  }
}

DI void lru_item(const Params& p, int l, int item, int pass, char* lds, int dry = 0) {
  const int n = item & 7, chunk = (item >> 3) & 63, b = item >> 9;
  float* xcs = (float*)lds;
  float* segP = xcs + 64 * 64;
  float* segH = segP + 256;
  const int tid = TID(), ch = tid & 63, tq = tid >> 6;
  const int chg = n * 64 + ch;
  const int t0 = chunk * 64 + tq * 16;
  const u16* zb = p.z + (size_t)b * S_ * ZS + XB + chg;
  const float* cw = p.conv_w + l * 4 * 512;
  const float w0 = cw[chg], w1 = cw[512 + chg], w2 = cw[1024 + chg], w3 = cw[1536 + chg];
  const float cb = p.conv_b[l * 512 + chg];
  float xm3 = (t0 >= 3) ? bf2f(zb[(size_t)(t0 - 3) * ZS]) : 0.f;
  float xm2 = (t0 >= 2) ? bf2f(zb[(size_t)(t0 - 2) * ZS]) : 0.f;
  float xm1 = (t0 >= 1) ? bf2f(zb[(size_t)(t0 - 1) * ZS]) : 0.f;
  float xc[16];
#pragma unroll
  for (int i = 0; i < 16; ++i) {
    const float cur = bf2f(zb[(size_t)(t0 + i) * ZS]);
    xc[i] = cb + w0 * xm3 + w1 * xm2 + w2 * xm1 + w3 * cur;
    xm3 = xm2; xm2 = xm1; xm1 = cur;
    xcs[(tq * 16 + i) * 64 + ch] = xc[i];
  }
  __syncthreads();
  float aA[16], aX[16];
#pragma unroll
  for (int i = 0; i < 16; ++i) { aA[i] = 0.f; aX[i] = 0.f; }
  const float* wa = p.w_rg_a + ((size_t)(l * 8 + n) * 64) * 64 + ch;
  const float* wx = p.w_rg_x + ((size_t)(l * 8 + n) * 64) * 64 + ch;
  for (int d = 0; d < 64; d += 4) {
    const float wa0 = wa[d * 64], wa1 = wa[(d + 1) * 64], wa2 = wa[(d + 2) * 64], wa3 = wa[(d + 3) * 64];
    const float wx0 = wx[d * 64], wx1 = wx[(d + 1) * 64], wx2 = wx[(d + 2) * 64], wx3 = wx[(d + 3) * 64];
#pragma unroll
    for (int i = 0; i < 16; ++i) {
      const float4 xv = *(const float4*)(xcs + (tq * 16 + i) * 64 + d);
      aA[i] += xv.x * wa0 + xv.y * wa1 + xv.z * wa2 + xv.w * wa3;
      aX[i] += xv.x * wx0 + xv.y * wx1 + xv.z * wx2 + xv.w * wx3;
    }
  }
  const float ba = p.b_rg_a[l * 512 + chg], bx = p.b_rg_x[l * 512 + chg], lam = p.lru_lambda[l * 512 + chg];
  const float sp = fmaxf(-lam, 0.f) + __logf(1.f + __expf(-fabsf(lam)));
  float P = 1.f, H = 0.f;
#pragma unroll
  for (int i = 0; i < 16; ++i) {
    const float rr = sigmoidf_(aA[i] + ba), ig = sigmoidf_(aX[i] + bx);
    const float la = -8.f * rr * sp;
    const float a = __expf(la);
    const float x2 = 2.f * la;
    const float em = (x2 > -0.1f) ? -x2 * (1.f + x2 * (0.5f + x2 * (0.16666667f + x2 * 0.041666667f))) : 1.f - __expf(x2);
    const float bb = sqrtf(fmaxf(em, 0.f)) * ig * xc[i];
    aA[i] = a; aX[i] = bb;
    H = a * H + bb;
    P *= a;
  }
  segP[tq * 64 + ch] = P;
  segH[tq * 64 + ch] = H;
  __syncthreads();
  if (pass == 1) {
    if (tq == 3) {
      float Pt = 1.f, Ht = 0.f;
#pragma unroll
      for (int s = 0; s < 4; ++s) { Ht = segP[s * 64 + ch] * Ht + segH[s * 64 + ch]; Pt *= segP[s * 64 + ch]; }
      float2 o; o.x = Pt; o.y = Ht;
      *(float2*)(p.lrusum + ((size_t)(b * 64 + chunk) * 512 + chg) * 2) = o;
    }
  } else {
    float hh = 0.f;
    for (int c = 0; c < chunk; ++c) {
      const float2 s = *(const float2*)(p.lrusum + ((size_t)(b * 64 + c) * 512 + chg) * 2);
      hh = s.x * hh + s.y;
    }
    for (int s = 0; s < tq; ++s) hh = segP[s * 64 + ch] * hh + segH[s * 64 + ch];
    u16* zg = p.z + ((size_t)b * S_ + t0) * ZS + GB + chg;
#pragma unroll
    for (int i = 0; i < 16; ++i) {
      hh = aA[i] * hh + aX[i];
      const float gt = bf2f(zg[(size_t)i * ZS]);
      u16* dst = dry ? ((u16*)(p.blkscr + (size_t)blockIdx.x * 8 * 256 + tid) + (i & 7)) : (zg + (size_t)i * ZS);
      *dst = f2bf(hh * siluf_(gt));
    }
  }
}

DI void cumsum_item(const Params& p, int l, int item, char* lds) {
  const int hd = item & 7, b = item >> 3;
  float* part = (float*)lds;
  const int tid = TID();
  const float bfv = p.b_forget[l * 8 + hd];
  const u16* zf = p.z + ((size_t)b * S_ + tid * 16) * ZS + FA + hd;
  float v[16], run = 0.f;
#pragma unroll
  for (int i = 0; i < 16; ++i) {
    const float f = bf2f(zf[(size_t)i * ZS]) + bfv;
    const float ls = fminf(f, 0.f) - __logf(1.f + __expf(-fabsf(f)));
    run += ls;
    v[i] = run;
  }
  part[tid] = run;
  __syncthreads();
  float pre = 0.f;
  for (int i = 0; i < tid; ++i) pre += part[i];
  float* dst = p.cbuf + (size_t)(b * 8 + hd) * S_ + tid * 16;
#pragma unroll
  for (int i = 0; i < 16; ++i) dst[i] = (pre + v[i]) * LOG2E;
}

DI void headnorm_item(const Params& p, int l, int item, int dry = 0) {
  const int tid = TID();
  for (int i = 0; i < 7; ++i) {
    const int vid = tid + 256 * i;
    const int tokl = vid / 28, hv = vid % 28;
    const size_t tok = (size_t)item * 64 + tokl;
    int col; const float* g; float sc = 1.f;
    if (hv < 8) { col = QA + hv * 64; g = p.qn_a + l * 64; sc = QSCALE; }
    else if (hv < 16) { col = KA + (hv - 8) * 64; g = p.kn_a + l * 64; }
    else if (hv < 24) { col = QC + (hv - 16) * 64; g = p.qn_c + l * 64; sc = QSCALE; }
    else if (hv < 26) { col = KSC + (hv - 24) * 64; g = p.kn_c + l * 64; }
    else { col = KWC + (hv - 26) * 64; g = p.kn_c + l * 64; }
    uint4* ptr = (uint4*)(p.z + tok * ZS + col);
    uint4 v[8];
    float ss = 0.f;
#pragma unroll
    for (int q = 0; q < 8; ++q) {
      v[q] = ptr[q];
      const unsigned uu[4] = {v[q].x, v[q].y, v[q].z, v[q].w};
#pragma unroll
      for (int e = 0; e < 4; ++e) { const float a = bflo(uu[e]), c = bfhi(uu[e]); ss += a * a + c * c; }
    }
    const float rs = rsqrtf(ss * (1.f / 64.f) + 1e-6f) * sc;
#pragma unroll
    for (int q = 0; q < 8; ++q) {
      const unsigned uu[4] = {v[q].x, v[q].y, v[q].z, v[q].w};
      unsigned oo[4];
#pragma unroll
      for (int e = 0; e < 4; ++e)
        oo[e] = pk2(bflo(uu[e]) * rs * g[q * 8 + 2 * e], bfhi(uu[e]) * rs * g[q * 8 + 2 * e + 1]);
      uint4* dp = dry ? (p.blkscr + (size_t)blockIdx.x * 8 * 256 + tid + (q & 7) * 256) : (ptr + q);
      *dp = make_uint4(oo[0], oo[1], oo[2], oo[3]);
    }
  }
}

DI void sgprep_item(const Params& p, int l, int item, int dry = 0) {
  const int lane = TID() & 63, w = TID() >> 6;
  const float* g = p.ln_v_g + l * 512 + lane * 8;
  for (int i = 0; i < 16; ++i) {
    const size_t tok = (size_t)item * 64 + w * 16 + i;
    uint4* ptr = (uint4*)(p.z + tok * ZS + VD + lane * 8);
    const uint4 v = *ptr;
    const unsigned uu[4] = {v.x, v.y, v.z, v.w};
    float f[8];
    float s = 0.f;
#pragma unroll
    for (int e = 0; e < 4; ++e) { f[2 * e] = geluf_(bflo(uu[e])); f[2 * e + 1] = geluf_(bfhi(uu[e])); s += f[2 * e] + f[2 * e + 1]; }
    const float mu = wave_sum(s) * (1.f / 512.f);
    float q = 0.f;
#pragma unroll
    for (int e = 0; e < 8; ++e) { f[e] -= mu; q += f[e] * f[e]; }
    const float rs = rsqrtf(wave_sum(q) * (1.f / 512.f) + 1e-6f);
    unsigned oo[4];
#pragma unroll
    for (int e = 0; e < 4; ++e) oo[e] = pk2(f[2 * e] * rs * g[2 * e], f[2 * e + 1] * rs * g[2 * e + 1]);
    uint4* dp = dry ? (p.blkscr + (size_t)blockIdx.x * 8 * 256 + TID()) : ptr;
    *dp = make_uint4(oo[0], oo[1], oo[2], oo[3]);
  }
}

DI void sg_item(const Params& p, int l, int item, char* lds, int dry) {
  const int g = item & 7, chunk = (item >> 3) & 31, b = item >> 8;
  float* vn = (float*)lds;
  const int tid = TID();
  const size_t tokbase = (size_t)b * S_ + chunk * 128;
#pragma unroll
  for (int i = 0; i < 4; ++i) {
    const int id = tid + 256 * i, row = id >> 3, c = id & 7;
    const uint4 v = *(const uint4*)(p.z + (tokbase + row) * ZS + VD + g * 64 + c * 8);
    float* d = vn + row * 64 + c * 8;
    d[0] = bflo(v.x); d[1] = bfhi(v.x); d[2] = bflo(v.y); d[3] = bfhi(v.y);
    d[4] = bflo(v.z); d[5] = bfhi(v.z); d[6] = bflo(v.w); d[7] = bfhi(v.w);
  }
  __syncthreads();
  const int d = tid & 63;
  const int tq = __builtin_amdgcn_readfirstlane(tid >> 6);
  const float* Wg = p.w_spatial + ((size_t)(l * 8 + g) * 128) * 128;
  const float* bs = p.b_spatial + (l * 8 + g) * 128;
  for (int i = 0; i < 32; ++i) {
    const int t = tq + 4 * i;
    const float* wr = Wg + t * 128;
    float acc = 0.f;
    for (int s = 0; s <= t; s += 4) {
      const float4 wv = *(const float4*)(wr + s);
      acc += wv.x * vn[s * 64 + d];
      if (s + 1 <= t) acc += wv.y * vn[(s + 1) * 64 + d];
      if (s + 2 <= t) acc += wv.z * vn[(s + 2) * 64 + d];
      if (s + 3 <= t) acc += wv.w * vn[(s + 3) * 64 + d];
    }
    const float mixed = acc + bs[t];
    u16* zr = p.z + (tokbase + t) * ZS;
    const float u = bf2f(zr[UD + g * 64 + d]);
    const float gd = bf2f(zr[GD + g * 64 + d]);
    u16* dst = dry ? ((u16*)(p.blkscr + (size_t)blockIdx.x * 8 * 256 + tid) + (i & 7)) : (zr + GD + g * 64 + d);
    *dst = f2bf(geluf_(u) * mixed * siluf_(gd));
  }
}

#define LDK 72
#define OFF_CK 36864
#define OFF_IMP 37376
#define OFF_SEL (OFF_IMP + 64 * 65 * 4)
#define OFF_WUNI (OFF_SEL + 512)
#define OFF_TL (OFF_WUNI + 64)
enum { M_FOX = 0, M_CMP = 1, M_CMP2 = 2, M_SLC = 3, M_WIN = 4 };

template <int MODE>
DI void attn_run(char* lds, const u16* __restrict__ Kg, const u16* __restrict__ Vg, int kstride,
                 const float* __restrict__ cgl, int nt, int first_tile, const bf16x8 (&qf)[2][4], f32x16 (&O)[2][2],
                 float (&m)[2], float (&l)[2], const int (&qpos)[2], const float (&cq)[2], const u64 (&selb)[2],
                 const float (&linv)[2], int wq0) {
  const int tid = TID(), lane = tid & 63, w = tid >> 6, r = lane & 31, h = lane >> 5;
  u16* Ks = (u16*)lds;
  u16* Vs = Ks + 2 * 64 * LDK;
  float* cks = (float*)(lds + OFF_CK);
  float* imp = (float*)(lds + OFF_IMP);
  const int* tlist = (const int*)(lds + OFF_TL);
  uint4 rk0, rk1, rv0 = make_uint4(0, 0, 0, 0), rv1 = make_uint4(0, 0, 0, 0);
  float rc = 0.f;
  const int lrow = tid >> 3, lcc = tid & 7;
  const int q4 = (lane & 15) >> 2, p4 = lane & 3, blk = (lane >> 4) & 1;

#define KEY0_OF(i_) ((MODE == M_SLC) ? tlist[(i_)] * 64 : (first_tile + (i_)) * 64)
#define ALOAD(i_)                                                                               \
  {                                                                                             \
    const int k0_ = KEY0_OF(i_);                                                                \
    rk0 = *(const uint4*)(Kg + (size_t)(k0_ + lrow) * kstride + lcc * 8);                       \
    rk1 = *(const uint4*)(Kg + (size_t)(k0_ + lrow + 32) * kstride + lcc * 8);                  \
    if (MODE != M_CMP2) {                                                                       \
      rv0 = *(const uint4*)(Vg + (size_t)(k0_ + lrow) * kstride + lcc * 8);                     \
      rv1 = *(const uint4*)(Vg + (size_t)(k0_ + lrow + 32) * kstride + lcc * 8);                \
    }                                                                                           \
    if (MODE == M_FOX && tid < 64) rc = cgl[k0_ + tid];                                         \
  }
#define ASTORE(b_)                                                                              \
  {                                                                                             \
    *(uint4*)(Ks + (b_) * 64 * LDK + lrow * LDK + lcc * 8) = rk0;                               \
    *(uint4*)(Ks + (b_) * 64 * LDK + (lrow + 32) * LDK + lcc * 8) = rk1;                        \
    if (MODE != M_CMP2) {                                                                       \
      *(uint4*)(Vs + (b_) * 64 * LDK + lrow * LDK + lcc * 8) = rv0;                             \
      *(uint4*)(Vs + (b_) * 64 * LDK + (lrow + 32) * LDK + lcc * 8) = rv1;                      \
    }                                                                                           \
    if (MODE == M_FOX && tid < 64) cks[(b_) * 64 + tid] = rc;                                   \
  }

  ALOAD(0);
  ASTORE(0);
  __syncthreads();
  for (int it = 0; it < nt; ++it) {
    if (it + 1 < nt) ALOAD(it + 1);
    const int key0 = KEY0_OF(it);
    const u16* Kt = Ks + (it & 1) * 64 * LDK;
    const u16* Vt = Vs + (it & 1) * 64 * LDK;
    const float* ckt = cks + (it & 1) * 64;
#pragma unroll
    for (int kb = 0; kb < 2; ++kb) {
      const int kbase = key0 + kb * 32;
      bool need = true;
      if (MODE == M_FOX || MODE == M_SLC) need = (kbase <= wq0 + 63);
      if (MODE == M_WIN) need = (kbase <= wq0 + 63) && (kbase + 31 > wq0 - 512);
      if (MODE == M_CMP) need = (16 * kbase + 31 <= wq0 + 63);
      float mainv[2][4], spill[2][4];
      if (need) {
        f32x16 S[2];
#pragma unroll
        for (int i = 0; i < 16; ++i) { S[0][i] = 0.f; S[1][i] = 0.f; }
#pragma unroll
        for (int ks = 0; ks < 4; ++ks) {
          const bf16x8 a = *(const bf16x8*)(Kt + (kb * 32 + r) * LDK + ks * 16 + 8 * h);
          S[0] = MFMA(a, qf[0][ks], S[0]);
          S[1] = MFMA(a, qf[1][ks], S[1]);
        }
        float ckv[16];
        if (MODE == M_FOX) {
#pragma unroll
          for (int a4 = 0; a4 < 4; ++a4) {
            const float4 c4 = *(const float4*)(ckt + kb * 32 + 8 * a4 + 4 * h);
            ckv[4 * a4] = c4.x; ckv[4 * a4 + 1] = c4.y; ckv[4 * a4 + 2] = c4.z; ckv[4 * a4 + 3] = c4.w;
          }
        }
        bf16x8 pk[2][2];
#pragma unroll
        for (int nb = 0; nb < 2; ++nb) {
          float sv[16];
          const int t = qpos[nb];
#pragma unroll
          for (int i = 0; i < 16; ++i) {
            const int kk = kbase + (i & 3) + 8 * (i >> 2) + 4 * h;
            float s = S[nb][i];
            bool valid;
            if (MODE == M_FOX) { s += cq[nb] - ckv[i]; valid = (kk <= t); }
            else if (MODE == M_CMP || MODE == M_CMP2) valid = (16 * kk + 31 <= t) && (kk < 255);
            else if (MODE == M_SLC) valid = (((selb[nb] >> (key0 >> 6)) & 1ull) != 0ull) && (kk <= t);
            else valid = (kk <= t) && (kk > t - 512);
            sv[i] = valid ? s : NEGBIG;
          }
          if (MODE == M_CMP2) {
#pragma unroll
            for (int a4 = 0; a4 < 4; ++a4) {
              float pe[4];
#pragma unroll
              for (int e = 0; e < 4; ++e)
                pe[e] = (sv[4 * a4 + e] > -5e29f) ? exp2f(sv[4 * a4 + e] - m[nb]) * linv[nb] : 0.f;
              mainv[nb][a4] = pe[0] + pe[1] + pe[2] + 0.5f * pe[3];
              spill[nb][a4] = 0.5f * pe[3];
            }
          } else {
            float mx = sv[0];
#pragma unroll
            for (int i = 1; i < 16; ++i) mx = fmaxf(mx, sv[i]);
            mx = fmaxf(mx, __shfl_xor(mx, 32));
            const float mnew = fmaxf(m[nb], mx);
            const float alpha = exp2f(m[nb] - mnew);
            m[nb] = mnew;
            float ps = 0.f;
#pragma unroll
            for (int i = 0; i < 16; ++i) {
              sv[i] = (sv[i] > -5e29f) ? exp2f(sv[i] - mnew) : 0.f;
              ps += sv[i];
            }
            l[nb] = l[nb] * alpha + ps;
#pragma unroll
            for (int i = 0; i < 16; ++i) { O[0][nb][i] *= alpha; O[1][nb][i] *= alpha; }
#pragma unroll
            for (int s2 = 0; s2 < 2; ++s2) {
              const unsigned u0 = pk2(sv[8 * s2], sv[8 * s2 + 1]), u1 = pk2(sv[8 * s2 + 2], sv[8 * s2 + 3]);
              const unsigned u2 = pk2(sv[8 * s2 + 4], sv[8 * s2 + 5]), u3 = pk2(sv[8 * s2 + 6], sv[8 * s2 + 7]);
              const uint4 uu = make_uint4(u0, u1, u2, u3);
              pk[nb][s2] = __builtin_bit_cast(bf16x8, uu);
            }
          }
        }
        if (MODE != M_CMP2) {
#pragma unroll
          for (int s2 = 0; s2 < 2; ++s2) {
#pragma unroll
            for (int db = 0; db < 2; ++db) {
              const u16* vp = Vt + (kb * 32 + 16 * s2 + 4 * h + q4) * LDK + db * 32 + 16 * blk + 4 * p4;
              const s16x4 lo = __builtin_amdgcn_ds_read_tr16_b64_v4i16((__attribute__((address_space(3))) s16x4*)(vp));
              const s16x4 hi = __builtin_amdgcn_ds_read_tr16_b64_v4i16((__attribute__((address_space(3))) s16x4*)(vp + 8 * LDK));
              const bf16x8 a = __builtin_shufflevector(lo, hi, 0, 1, 2, 3, 4, 5, 6, 7);
              O[db][0] = MFMA(a, pk[0][s2], O[db][0]);
              O[db][1] = MFMA(a, pk[1][s2], O[db][1]);
            }
          }
        }
      }
      if (MODE == M_CMP2) {
        const int jb = (kbase >> 2) + h;
        for (int rr = 0; rr < 4; ++rr) {
          if (w == rr) {
#pragma unroll
            for (int nb = 0; nb < 2; ++nb)
#pragma unroll
              for (int a4 = 0; a4 < 4; ++a4) imp[(nb * 32 + r) * 65 + jb + 2 * a4] += mainv[nb][a4];
#pragma unroll
            for (int nb = 0; nb < 2; ++nb)
#pragma unroll
              for (int a4 = 0; a4 < 4; ++a4) imp[(nb * 32 + r) * 65 + jb + 2 * a4 + 1] += spill[nb][a4];
          }
          __syncthreads();
        }
      }
    }
    if (it + 1 < nt) ASTORE((it + 1) & 1);
    __syncthreads();
  }
#undef KEY0_OF
#undef ALOAD
#undef ASTORE
}

DI void attn_init(f32x16 (&O)[2][2], float (&m)[2], float (&l)[2]) {
#pragma unroll
  for (int a = 0; a < 2; ++a)
#pragma unroll
    for (int b = 0; b < 2; ++b)
#pragma unroll
      for (int i = 0; i < 16; ++i) O[a][b][i] = 0.f;
  m[0] = m[1] = NEGBIG;
  l[0] = l[1] = 0.f;
}

DI void fox_item(const Params& p, int l_, int item, char* lds, int dry) {
  const int qb = 15 - (item >> 5), bh = item & 31, b = bh >> 3, hd = bh & 7;
  const int tid = TID(), lane = tid & 63, w = tid >> 6, r = lane & 31, h = lane >> 5;
  const int wq0 = qb * 256 + w * 64;
  const int qpos[2] = {wq0 + r, wq0 + 32 + r};
  u16* zb = p.z + (size_t)b * S_ * ZS;
  bf16x8 qf[2][4];
#pragma unroll
  for (int nb = 0; nb < 2; ++nb)
#pragma unroll
    for (int ks = 0; ks < 4; ++ks)
      qf[nb][ks] = *(const bf16x8*)(zb + (size_t)qpos[nb] * ZS + QA + hd * 64 + ks * 16 + 8 * h);
  const float* cb = p.cbuf + (size_t)(b * 8 + hd) * S_;
  const float cq[2] = {cb[qpos[0]], cb[qpos[1]]};
  f32x16 O[2][2];
  float m[2], l[2];
  attn_init(O, m, l);
  const u64 selb[2] = {0ull, 0ull};
  const float linv[2] = {0.f, 0.f};
  attn_run<M_FOX>(lds, zb + KA + hd * 64, zb + VA + hd * 64, ZS, cb, 4 * (qb + 1), 0, qf, O, m, l, qpos, cq, selb, linv, wq0);
#pragma unroll
  for (int nb = 0; nb < 2; ++nb) {
    const float lt = l[nb] + __shfl_xor(l[nb], 32);
    const float inv = (lt > 0.f) ? 1.f / lt : 0.f;
    u16* zr = zb + (size_t)qpos[nb] * ZS + GA + hd * 64;
#pragma unroll
    for (int db = 0; db < 2; ++db)
#pragma unroll
      for (int a4 = 0; a4 < 4; ++a4) {
        uint2* gp = (uint2*)(zr + db * 32 + 8 * a4 + 4 * h);
        const uint2 gv = *gp;
        uint2 o;
        o.x = pk2(O[db][nb][4 * a4] * inv * siluf_(bflo(gv.x)), O[db][nb][4 * a4 + 1] * inv * siluf_(bfhi(gv.x)));
        o.y = pk2(O[db][nb][4 * a4 + 2] * inv * siluf_(bflo(gv.y)), O[db][nb][4 * a4 + 3] * inv * siluf_(bfhi(gv.y)));
        if (dry) gp = (uint2*)(p.blkscr + (size_t)blockIdx.x * 8 * 256 + tid + ((nb * 8 + db * 4 + a4) >> 1) * 256) + (a4 & 1);
        *gp = o;
      }
  }
}

DI void nsa_item(const Params& p, int l_, int item, char* lds, int dry) {
  const int qb = 63 - (item >> 3), bg = item & 7, b = bg >> 1, g = bg & 1;
  const int tid = TID(), lane = tid & 63, w = tid >> 6, r = lane & 31, h = lane >> 5;
  const int head = g * 4 + w;
  float* imp = (float*)(lds + OFF_IMP);
  u64* selm = (u64*)(lds + OFF_SEL);
  u64* wuni = (u64*)(lds + OFF_WUNI);
  int* tlist = (int*)(lds + OFF_TL);
  for (int i = tid; i < 64 * 65; i += 256) imp[i] = 0.f;
  const int wq0 = qb * 64;
  const int qpos[2] = {wq0 + r, wq0 + 32 + r};
  u16* zb = p.z + (size_t)b * S_ * ZS;
  bf16x8 qf[2][4];
#pragma unroll
  for (int nb = 0; nb < 2; ++nb)
#pragma unroll
    for (int ks = 0; ks < 4; ++ks)
      qf[nb][ks] = *(const bf16x8*)(zb + (size_t)qpos[nb] * ZS + QC + head * 64 + ks * 16 + 8 * h);
  uint4* scr = p.blkscr + (size_t)blockIdx.x * 8 * 256 + tid;
#define NSA_GATE(c_, nb_) sigmoidf_(bf2f(zb[(size_t)qpos[nb_] * ZS + GATEC + (c_) * 8 + head]))
  const float cq[2] = {0.f, 0.f};
  u64 selb[2] = {0ull, 0ull};
  float linv[2] = {0.f, 0.f};
  f32x16 O[2][2];
  float m[2], l[2];

  attn_init(O, m, l);
  const u16* kcp = p.kc + (size_t)(b * 2 + g) * 256 * 64;
  const u16* vcp = p.vc + (size_t)(b * 2 + g) * 256 * 64;
  attn_run<M_CMP>(lds, kcp, vcp, 64, nullptr, 4, 0, qf, O, m, l, qpos, cq, selb, linv, wq0);
#pragma unroll
  for (int nb = 0; nb < 2; ++nb) {
    const float lt = l[nb] + __shfl_xor(l[nb], 32);
    linv[nb] = (lt > 0.f) ? 1.f / lt : 0.f;
    const float sc = linv[nb] * NSA_GATE(0, nb);
#pragma unroll
    for (int db = 0; db < 2; ++db)
#pragma unroll
      for (int i = 0; i < 2; ++i) {
        uint4 o;
        o.x = pk2(O[db][nb][8 * i] * sc, O[db][nb][8 * i + 1] * sc);
        o.y = pk2(O[db][nb][8 * i + 2] * sc, O[db][nb][8 * i + 3] * sc);
        o.z = pk2(O[db][nb][8 * i + 4] * sc, O[db][nb][8 * i + 5] * sc);
        o.w = pk2(O[db][nb][8 * i + 6] * sc, O[db][nb][8 * i + 7] * sc);
        scr[((nb * 2 + db) * 2 + i) * 256] = o;
      }
  }
  attn_run<M_CMP2>(lds, kcp, vcp, 64, nullptr, 4, 0, qf, O, m, l, qpos, cq, selb, linv, wq0);
  {
    u64 uni = 0ull;
    const int j = lane;
    const bool valid = (j <= qb);
    const bool forced = (j == 0) || (valid && j > qb - 2);
    for (int qq = 0; qq < 16; ++qq) {
      const int q = 16 * w + qq;
      const float sc = forced ? 1e6f : (valid ? imp[q * 65 + j] : -1.f);
      int rank = 0;
#pragma unroll
      for (int i = 0; i < 64; ++i) {
        const float si = __shfl(sc, i);
        rank += ((si > sc) || (si == sc && i < j)) ? 1 : 0;
      }
      const bool sel = (rank < 16) && (sc >= 0.f);
      const u64 mk = __ballot(sel);
      if (lane == 0) selm[q] = mk;
      uni |= mk;
    }
    if (lane == 0) wuni[w] = uni;
  }
  __syncthreads();
  const u64 U = wuni[0] | wuni[1] | wuni[2] | wuni[3];
  if (w == 0 && ((U >> lane) & 1ull)) tlist[__popcll(U & ((1ull << lane) - 1ull))] = lane;
  const int ntl = __popcll(U);
  selb[0] = selm[r];
  selb[1] = selm[32 + r];
  __syncthreads();
  attn_init(O, m, l);
  attn_run<M_SLC>(lds, zb + KSC + g * 64, zb + VSC + g * 64, ZS, nullptr, ntl, 0, qf, O, m, l, qpos, cq, selb, linv, wq0);
#pragma unroll
  for (int nb = 0; nb < 2; ++nb) {
    const float lt = l[nb] + __shfl_xor(l[nb], 32);
    const float sc = ((lt > 0.f) ? 1.f / lt : 0.f) * NSA_GATE(1, nb);
#pragma unroll
    for (int db = 0; db < 2; ++db)
#pragma unroll
      for (int i = 0; i < 2; ++i) {
        uint4 o = scr[((nb * 2 + db) * 2 + i) * 256];
        o.x = pk2(bflo(o.x) + O[db][nb][8 * i] * sc, bfhi(o.x) + O[db][nb][8 * i + 1] * sc);
        o.y = pk2(bflo(o.y) + O[db][nb][8 * i + 2] * sc, bfhi(o.y) + O[db][nb][8 * i + 3] * sc);
        o.z = pk2(bflo(o.z) + O[db][nb][8 * i + 4] * sc, bfhi(o.z) + O[db][nb][8 * i + 5] * sc);
        o.w = pk2(bflo(o.w) + O[db][nb][8 * i + 6] * sc, bfhi(o.w) + O[db][nb][8 * i + 7] * sc);
        scr[((nb * 2 + db) * 2 + i) * 256] = o;
      }
  }
  attn_init(O, m, l);
  const int first = (qb >= 8) ? qb - 8 : 0;
  attn_run<M_WIN>(lds, zb + KWC + g * 64, zb + VWC + g * 64, ZS, nullptr, qb - first + 1, first, qf, O, m, l, qpos, cq, selb, linv, wq0);
#pragma unroll
  for (int nb = 0; nb < 2; ++nb) {
    const float lt = l[nb] + __shfl_xor(l[nb], 32);
    const float sc = ((lt > 0.f) ? 1.f / lt : 0.f) * NSA_GATE(2, nb);
    u16* zr = zb + (size_t)qpos[nb] * ZS + GC + head * 64;
#pragma unroll
    for (int db = 0; db < 2; ++db)
#pragma unroll
      for (int a4 = 0; a4 < 4; ++a4) {
        uint2* gp = (uint2*)(zr + db * 32 + 8 * a4 + 4 * h);
        const uint2 gv = *gp;
        const uint2 pv = *((const uint2*)&scr[((nb * 2 + db) * 2 + (a4 >> 1)) * 256] + (a4 & 1));
        const unsigned o0 = pv.x, o1 = pv.y;
        uint2 o;
        o.x = pk2((bflo(o0) + O[db][nb][4 * a4] * sc) * siluf_(bflo(gv.x)),
                  (bfhi(o0) + O[db][nb][4 * a4 + 1] * sc) * siluf_(bfhi(gv.x)));
        o.y = pk2((bflo(o1) + O[db][nb][4 * a4 + 2] * sc) * siluf_(bflo(gv.y)),
                  (bfhi(o1) + O[db][nb][4 * a4 + 3] * sc) * siluf_(bfhi(gv.y)));
        if (dry) gp = (uint2*)&scr[((nb * 2 + db) * 2 + (a4 >> 1)) * 256] + (a4 & 1);
        *gp = o;
      }
  }
}

#define XB_TMO      128
#define XB_XCNT(j)  (256  + 64 * (j))
#define XB_XSUB(j)  (1280 + 64 * (j))
#define XB_XGEN(j)  (2304 + 64 * (j))
#define XB_TOP      3328
#define XB_TOPGEN   3392
#define XCD_BAR_WORDS 3456
#define XB_SPIN_CAP (1u << 18)
#define LAS __attribute__((address_space(3)))

__device__ __forceinline__ unsigned xb_ld(unsigned* p)              { return __hip_atomic_load(p, __ATOMIC_RELAXED, __HIP_MEMORY_SCOPE_AGENT); }
__device__ __forceinline__ unsigned xb_add(unsigned* p, unsigned v) { return __hip_atomic_fetch_add(p, v, __ATOMIC_RELAXED, __HIP_MEMORY_SCOPE_AGENT); }
__device__ __forceinline__ unsigned xb_xcc_id() { return (unsigned)__builtin_amdgcn_s_getreg((3 << 11) | 20) & 0xFu; }
#define XB_SPIN(cond, bar) do { unsigned _sp = 0; while (cond) { __builtin_amdgcn_s_sleep(1); \
    if ((++_sp & 255u) == 0u) { if (xb_ld(&(bar)[XB_TMO])) break; if (_sp > XB_SPIN_CAP) { atomicAdd(&(bar)[XB_TMO], 1u); break; } } } } while (0)

struct XcdBarrier {
    unsigned* bar; unsigned x;
    volatile LAS unsigned* st;
};

__device__ __forceinline__ XcdBarrier xcd_barrier_post(unsigned* bar, volatile LAS unsigned* st) {
    XcdBarrier b; b.bar = bar; b.x = xb_xcc_id(); b.st = st;
    if (threadIdx.x == 0) (void)xb_add(&bar[XB_XCNT(b.x)], 1u);
    return b;
}
__device__ __forceinline__ void xcd_barrier_complete(unsigned* bar, unsigned x, unsigned& nloc, unsigned& nx) {
    const unsigned G = gridDim.x * gridDim.y * gridDim.z;
    unsigned sum, cnt, mine, sp = 0u;
    for (;;) {
        sum = 0u; cnt = 0u; mine = 0u;
#pragma unroll
        for (unsigned j = 0; j < 16; ++j) { const unsigned c = xb_ld(&bar[XB_XCNT(j)]); sum += c; cnt += (c > 0u) ? 1u : 0u; mine = (j == x) ? c : mine; }
        if (sum == G) break;
        __builtin_amdgcn_s_sleep(1);
        if ((++sp & 255u) == 0u) { if (xb_ld(&bar[XB_TMO])) break; if (sp > XB_SPIN_CAP) { atomicAdd(&bar[XB_TMO], 1u); break; } }
    }
    nloc = mine > 0u ? mine : 1u; nx = cnt > 0u ? cnt : 1u;
}

__device__ __forceinline__ void xcd_barrier(const XcdBarrier& b) {
    asm volatile("s_waitcnt vmcnt(0)" ::: "memory");
    __syncthreads();
    if (threadIdx.x == 0) {
        unsigned* bar = b.bar;
        __builtin_amdgcn_s_waitcnt(0);
        unsigned nloc = b.st[0], nx = b.st[1];
        if (nloc == 0u) { xcd_barrier_complete(bar, b.x, nloc, nx); b.st[0] = nloc; b.st[1] = nx; }
        const unsigned old = xb_add(&bar[XB_XSUB(b.x)], 1u);
        const unsigned gen = old / nloc;
        if (old + 1u == (gen + 1u) * nloc) {
            __builtin_amdgcn_fence(__ATOMIC_RELEASE, "agent");
            asm volatile("s_waitcnt vmcnt(0)" ::: "memory");
            const unsigned og = xb_add(&bar[XB_TOP], 1u);
            const unsigned tg = og / nx;
            if (og + 1u == (tg + 1u) * nx) xb_add(&bar[XB_TOPGEN], 1u);
            else XB_SPIN(xb_ld(&bar[XB_TOPGEN]) == tg, bar);
            __builtin_amdgcn_fence(__ATOMIC_ACQUIRE, "agent");
            xb_add(&bar[XB_XGEN(b.x)], 1u);
            asm volatile("s_waitcnt vmcnt(0)" ::: "memory");
        } else {
            XB_SPIN(xb_ld(&bar[XB_XGEN(b.x)]) == gen, bar);
            __builtin_amdgcn_fence(__ATOMIC_ACQUIRE, "agent");
            asm volatile("s_waitcnt vmcnt(0)" ::: "memory");
        }
    }
    __syncthreads();
}


__global__ void __launch_bounds__(256, 2) hybrid_fwd(Params p) {
  cg::grid_group grid = cg::this_grid();
  __shared__ __attribute__((aligned(16))) char lds[LDS_BYTES];
  __shared__ int slot;
  __shared__ uint4 xb_words;
  if (threadIdx.x == 0) xb_words = make_uint4(0u, 0u, 0u, 0u);
  __syncthreads();
  const XcdBarrier xb = xcd_barrier_post(p.bar, (volatile LAS unsigned*)&xb_words);
  for (int l = 0; l < 2; ++l) {
    const float* xin = (l == 0) ? p.x : p.out;
    for (int rep = 0; rep < REP_P0; ++rep) phase0(p, l, xin, lds);
    if (l == 0) grid.sync(); else xcd_barrier(xb);
    for (int rep = 0; rep < REP_P1; ++rep) phase1(p, lds);
    xcd_barrier(xb);
    {
      for (int rep = 0; rep < REP_P2; ++rep) {
        int* ctr = p.ctr + l * 2 + rep * 8;
        const int dry = (rep + 1 < REP_P2) ? 1 : 0;
        for (;;) {
          const int it = pop_item(ctr, &slot);
          if (it >= 2624) break;
          if (it < 32) { if (!dry || (P2_MASK & 1)) compress_item(p, l, it, lds); }
          else if (it < 2080) { if (!dry || (P2_MASK & 2)) lru_item(p, l, it - 32, 1, lds); }
          else if (it < 2112) { if (!dry || (P2_MASK & 4)) cumsum_item(p, l, it - 2080, lds); }
          else if (it < 2368) { if (!dry || (P2_MASK & 8)) headnorm_item(p, l, it - 2112, dry); }
          else { if (!dry || (P2_MASK & 16)) sgprep_item(p, l, it - 2368, dry); }
        }
      }
    }
    xcd_barrier(xb);
    {
      for (int rep = 0; rep < REP_P3; ++rep) {
        int* ctr = p.ctr + l * 2 + 1 + rep * 4;
        const int dry = (rep + 1 < REP_P3) ? 1 : 0;
        for (;;) {
          const int it = pop_item(ctr, &slot);
          if (it >= 4096) break;
          if (it < 512) { if (!dry || (P3_MASK & 1)) nsa_item(p, l, it, lds, dry); }
          else if (it < 1024) { if (!dry || (P3_MASK & 2)) fox_item(p, l, it - 512, lds, dry); }
          else if (it < 3072) { if (!dry || (P3_MASK & 4)) lru_item(p, l, it - 1024, 2, lds, dry); }
          else { if (!dry || (P3_MASK & 8)) sg_item(p, l, it - 3072, lds, dry); }
        }
      }
    }
    xcd_barrier(xb);
    for (int rep = 0; rep < REP_P4; ++rep) phase4(p, lds);
    xcd_barrier(xb);
    for (int rep = 0; rep < ((l == 0) ? REP_P5 : 1); ++rep) phase5(p, xin, p.out, lds);
    if (l == 0) xcd_barrier(xb);
  }
}

extern "C" void kernel_launch(void* const* d_in, const int* in_sizes, int n_in, void* d_out, int out_size, void* d_ws,
                              size_t ws_size, hipStream_t stream) {
  static int grid_blocks = 0;
  if (!grid_blocks) {
    int dev = 0, cus = 0, per_cu = 0;
    hipGetDevice(&dev);
    hipDeviceGetAttribute(&cus, hipDeviceAttributeMultiprocessorCount, dev);
    hipOccupancyMaxActiveBlocksPerMultiprocessor(&per_cu, hybrid_fwd, 256, 0);
    if (per_cu > 2) per_cu = 2;
    if (per_cu < 1) per_cu = 1;
    grid_blocks = cus * per_cu;
  }
  Params p{};
  const float** f = (const float**)&p;
  for (int i = 0; i < 25; ++i) f[i] = (const float*)d_in[i];
  p.out = (float*)d_out;
  char* ws = (char*)d_ws;
  size_t off = 0;
  auto take = [&](size_t bytes) { char* r = ws + off; off += (bytes + 255) & ~(size_t)255; return r; };
  p.ctr = (int*)take(256);
  p.bar = (unsigned*)take((size_t)XCD_BAR_WORDS * 4);
  p.z = (u16*)take((size_t)T_ * ZS * 2);
  p.xn = (u16*)take((size_t)T_ * 1024 * 2);
  p.WinT = (u16*)take((size_t)6528 * 1024 * 2);
  p.WgT = (u16*)take((size_t)4096 * 1024 * 2);
  p.WbT = (u16*)take((size_t)4 * 1024 * 512 * 2);
  p.WoT = (u16*)take((size_t)1024 * 1024 * 2);
  p.cbuf = (float*)take((size_t)4 * 8 * S_ * 4);
  p.lrusum = (float*)take((size_t)4 * 64 * 512 * 2 * 4);
  p.kc = (u16*)take((size_t)4 * 2 * 256 * 64 * 2);
  p.vc = (u16*)take((size_t)4 * 2 * 256 * 64 * 2);
  p.W1T = (u16*)take((size_t)2 * 128 * 2048 * 2);
  p.pospart = (float*)take((size_t)2 * 32 * 128 * 4);
  p.blkscr = (uint4*)take((size_t)grid_blocks * 8 * 256 * 16);
  hipMemsetAsync(p.ctr, 0, 256 + (((size_t)XCD_BAR_WORDS * 4 + 255) & ~(size_t)255), stream);
  void* args[] = {&p};
  hipError_t e = hipLaunchCooperativeKernel((void*)hybrid_fwd, dim3(grid_blocks), dim3(256), args, 0, stream);
  if (e != hipSuccess) fprintf(stderr, "cooperative launch failed: %s (grid %d)\n", hipGetErrorString(e), grid_blocks);
}
```

```cpp
#include <hip/hip_runtime.h>
#include <hip/hip_cooperative_groups.h>
#include <cstdio>
namespace cg = cooperative_groups;

typedef unsigned short u16;
typedef unsigned long long u64;
typedef short bf16x8 __attribute__((ext_vector_type(8)));
typedef short s16x4 __attribute__((ext_vector_type(4)));
typedef float f32x16 __attribute__((ext_vector_type(16)));
typedef __bf16 bf2_t __attribute__((ext_vector_type(2)));
typedef float f2_t __attribute__((ext_vector_type(2)));

#define DI __device__ __forceinline__
#define MFMA(a, b, c) __builtin_amdgcn_mfma_f32_32x32x16_bf16((a), (b), (c), 0, 0, 0)

#define S_ 4096
#define T_ 16384
#define ZS 6528
#define QA 0
#define KA 512
#define VA 1024
#define GA 1536
#define XB 2048
#define GB 2560
#define QC 3072
#define KCC 3584
#define VCC 3712
#define KSC 3840
#define VSC 3968
#define KWC 4096
#define VWC 4224
#define GC 4352
#define UD 4864
#define VD 5376
#define GD 5888
#define FA 6400
#define GATEC 6408
#define LOG2E 1.4426950408889634f
#define QSCALE (0.125f * LOG2E)
#define NEGBIG (-1e30f)
#define LDS_BYTES 73728
#ifndef REP_P0
#define REP_P0 1
#endif
#ifndef REP_P1
#define REP_P1 1
#endif
#ifndef REP_P2
#define REP_P2 1
#endif
#ifndef P2_MASK
#define P2_MASK 31
#endif
#ifndef REP_P5
#define REP_P5 1
#endif
#ifndef REP_P3
#define REP_P3 1
#endif
#ifndef P3_MASK
#define P3_MASK 15
#endif
#ifndef REP_P4
#define REP_P4 1
#endif

struct Params {
  const float *x, *norm_g, *w_in, *b_forget, *qn_a, *kn_a, *conv_w, *conv_b, *w_rg_a, *b_rg_a, *w_rg_x, *b_rg_x,
      *lru_lambda, *qn_c, *kn_c, *cmp_pos, *cmp_k_w1, *cmp_k_w2, *cmp_v_w1, *cmp_v_w2, *ln_v_g, *w_spatial,
      *b_spatial, *w_branch, *w_out;
  float* out;
  int* ctr;
  u16 *z, *xn, *WinT, *WgT, *WbT, *WoT;
  float *cbuf, *lrusum;
  u16 *kc, *vc;
  uint4* blkscr;
  u16* W1T;
  float* pospart;
  unsigned* bar;
};

DI unsigned pk2(float a, float b) { f2_t v = {a, b}; bf2_t r = __builtin_convertvector(v, bf2_t); return __builtin_bit_cast(unsigned, r); }
DI float bflo(unsigned u) { return __uint_as_float(u << 16); }
DI float bfhi(unsigned u) { return __uint_as_float(u & 0xffff0000u); }
DI float bf2f(u16 v) { return __uint_as_float(((unsigned)v) << 16); }
DI u16 f2bf(float x) { return (u16)(pk2(x, 0.f) & 0xffffu); }
DI float sigmoidf_(float x) { return 1.f / (1.f + __expf(-x)); }
DI float siluf_(float x) { return x / (1.f + __expf(-x)); }
DI float geluf_(float x) { return 0.5f * x * (1.f + erff(x * 0.70710678118654752f)); }
DI float shx(float v, int lane, int mask) {
  return __int_as_float(__builtin_amdgcn_ds_bpermute((lane ^ mask) << 2, __float_as_int(v)));
}
DI float wave_sum(float v, int lane) {
#pragma unroll
  for (int o = 32; o > 0; o >>= 1) v += shx(v, lane, o);
  return v;
}
DI int TID() { int t = threadIdx.x; asm volatile("" : "+v"(t)); return t; }
DI int pop_item(int* ctr, int* slot) {
  __syncthreads();
  if (threadIdx.x == 0) *slot = atomicAdd(ctr, 1);
  __syncthreads();
  return *slot;
}

#define LDT 72
#define GEMM_GL1(P, i_, kt_)                                                                           \
  P##a##i_ = *(const uint4*)(Ag + (size_t)(row0 + 32 * i_) * lda + (size_t)(kt_) * akstep + cc * 8);   \
  P##b##i_ = *(const uint4*)(Bg + (size_t)(row0 + 32 * i_) * ldb + (kt_) * 64 + cc * 8);
#define GEMM_GLOAD(P, kt_) { GEMM_GL1(P, 0, kt_) GEMM_GL1(P, 1, kt_) GEMM_GL1(P, 2, kt_) GEMM_GL1(P, 3, kt_) }
#define GEMM_LS1(P, i_, buf_)                                                                  \
  *(uint4*)(As + (buf_) * 128 * LDT + (row0 + 32 * i_) * LDT + cc * 8) = P##a##i_;              \
  *(uint4*)(Bs + (buf_) * 128 * LDT + (row0 + 32 * i_) * LDT + cc * 8) = P##b##i_;
#define GEMM_LSTORE(P, buf_) { GEMM_LS1(P, 0, buf_) GEMM_LS1(P, 1, buf_) GEMM_LS1(P, 2, buf_) GEMM_LS1(P, 3, buf_) }
#define GEMM_COMPUTE(buf_)                                                                               \
  {                                                                                                      \
    const u16* a_ = As + (buf_) * 128 * LDT + (wm * 64 + r) * LDT + 8 * h;                               \
    const u16* b_ = Bs + (buf_) * 128 * LDT + (wn * 64 + r) * LDT + 8 * h;                               \
    _Pragma("unroll") for (int ks = 0; ks < 4; ++ks) {                                                   \
      const bf16x8 a0 = *(const bf16x8*)(a_ + ks * 16);                                                  \
      const bf16x8 a1 = *(const bf16x8*)(a_ + 32 * LDT + ks * 16);                                       \
      const bf16x8 b0 = *(const bf16x8*)(b_ + ks * 16);                                                  \
      const bf16x8 b1 = *(const bf16x8*)(b_ + 32 * LDT + ks * 16);                                       \
      acc[0][0] = MFMA(b0, a0, acc[0][0]);                                                               \
      acc[0][1] = MFMA(b1, a0, acc[0][1]);                                                               \
      acc[1][0] = MFMA(b0, a1, acc[1][0]);                                                               \
      acc[1][1] = MFMA(b1, a1, acc[1][1]);                                                               \
    }                                                                                                    \
  }
template <bool DEEP>
DI void gemm_mainloop_t(const u16* __restrict__ Ag, int lda, const u16* __restrict__ Bg, int ldb, int K, char* ldsraw,
                        f32x16 (&acc)[2][2], int akstep) {
  const int tid = TID(), lane = tid & 63, w = tid >> 6, wm = w >> 1, wn = w & 1, r = lane & 31, h = lane >> 5;
  u16* As = (u16*)ldsraw;
  u16* Bs = As + 2 * 128 * LDT;
  uint4 xa0, xa1, xa2, xa3, xb0, xb1, xb2, xb3;
  const int nk = K >> 6;
  const int row0 = tid >> 3, cc = tid & 7;
  if (DEEP) {
    uint4 ya0, ya1, ya2, ya3, yb0, yb1, yb2, yb3;
    GEMM_GLOAD(x, 0);
    GEMM_GLOAD(y, 1);
    GEMM_LSTORE(x, 0);
    __syncthreads();
    for (int kt = 0; kt < nk; kt += 2) {
      if (kt + 2 < nk) GEMM_GLOAD(x, kt + 2);
      GEMM_COMPUTE(0);
      GEMM_LSTORE(y, 1);
      __syncthreads();
      if (kt + 3 < nk) GEMM_GLOAD(y, kt + 3);
      GEMM_COMPUTE(1);
      if (kt + 2 < nk) GEMM_LSTORE(x, 0);
      __syncthreads();
    }
  } else {
    GEMM_GLOAD(x, 0);
    GEMM_LSTORE(x, 0);
    __syncthreads();
    for (int kt = 0; kt < nk; kt += 2) {
      GEMM_GLOAD(x, kt + 1);
      GEMM_COMPUTE(0);
      GEMM_LSTORE(x, 1);
      __syncthreads();
      if (kt + 2 < nk) GEMM_GLOAD(x, kt + 2);
      GEMM_COMPUTE(1);
      if (kt + 2 < nk) GEMM_LSTORE(x, 0);
      __syncthreads();
    }
  }
}
DI void gemm_mainloop(const u16* __restrict__ Ag, int lda, const u16* __restrict__ Bg, int ldb, int K, char* ldsraw,
                      f32x16 (&acc)[2][2], int akstep = 64) {
  gemm_mainloop_t<true>(Ag, lda, Bg, ldb, K, ldsraw, acc, akstep);
}
DI void gemm_mainloop_shallow(const u16* __restrict__ Ag, int lda, const u16* __restrict__ Bg, int ldb, int K, char* ldsraw,
                              f32x16 (&acc)[2][2]) {
  gemm_mainloop_t<false>(Ag, lda, Bg, ldb, K, ldsraw, acc, 64);
}

DI void zero_acc(f32x16 (&acc)[2][2]) {
#pragma unroll
  for (int a = 0; a < 2; ++a)
#pragma unroll
    for (int b = 0; b < 2; ++b)
#pragma unroll
      for (int i = 0; i < 16; ++i) acc[a][b][i] = 0.f;
}

DI int win_srccol(int n) {
  if (n < 1536) return n;
  if (n < 4352) return n + 8;
  if (n < 6400) return n + 32;
  if (n < 6408) return 1536 + (n - 6400);
  if (n < 6432) return 4360 + (n - 6408);
  return -1;
}
DI void transpose_tile(const float* __restrict__ src, int sld, int k0, int n0, int kind, u16* __restrict__ dst, int dld,
                       char* ldsraw) {
  float* t = (float*)ldsraw;
  const int tid = TID();
  {
    const int nn = tid & 63, kq = tid >> 6;
    const int n = n0 + nn;
    const int sc = (kind == 0) ? win_srccol(n) : ((kind == 1) ? 6432 + n : n);
#pragma unroll
    for (int i = 0; i < 16; ++i) {
      const int kk = kq * 16 + i;
      t[kk * 65 + nn] = (sc >= 0) ? src[(size_t)(k0 + kk) * sld + sc] : 0.f;
    }
  }
  __syncthreads();
  {
    const int nn = tid >> 2, ks = (tid & 3) * 16;
    unsigned o[8];
#pragma unroll
    for (int i = 0; i < 8; ++i) o[i] = pk2(t[(ks + 2 * i) * 65 + nn], t[(ks + 2 * i + 1) * 65 + nn]);
    uint4* d = (uint4*)(dst + (size_t)(n0 + nn) * dld + k0 + ks);
    d[0] = make_uint4(o[0], o[1], o[2], o[3]);
    d[1] = make_uint4(o[4], o[5], o[6], o[7]);
  }
  __syncthreads();
}

DI void phase0(const Params& p, int l, const float* __restrict__ xin, char* lds) {
  const int NI = 1632 + 1024 + 512 + 256 + 256 + 128 + 64;
  for (int it = blockIdx.x; it < NI; it += gridDim.x) {
    if (it < 1632) {
      transpose_tile(p.w_in + (size_t)l * 1024 * 10528, 10528, (it & 15) * 64, (it >> 4) * 64, 0, p.WinT, 1024, lds);
    } else if (it < 2656) {
      const int j = it - 1632;
      transpose_tile(p.w_in + (size_t)l * 1024 * 10528, 10528, (j & 15) * 64, (j >> 4) * 64, 1, p.WgT, 1024, lds);
    } else if (it < 3168) {
      const int j = it - 2656;
      const int n = j >> 7;
      transpose_tile(p.w_branch + ((size_t)(l * 4 + n) * 512) * 1024, 1024, (j & 7) * 64, ((j >> 3) & 15) * 64, 2,
                     p.WbT + (size_t)n * 1024 * 512, 512, lds);
    } else if (it < 3424) {
      const int j = it - 3168;
      transpose_tile(p.w_out + (size_t)l * 1024 * 1024, 1024, (j & 15) * 64, (j >> 4) * 64, 2, p.WoT, 1024, lds);
    } else if (it >= 3808) {
      const int j = it - 3808, kv = j >> 5, kc = j & 31;
      const int tid = TID(), n = tid & 127, kh = tid >> 7;
      const float* w1 = (kv ? p.cmp_v_w1 : p.cmp_k_w1) + (size_t)l * 2048 * 128;
      const float* pos = p.cmp_pos + l * 2048;
      float a = 0.f;
#pragma unroll 8
      for (int k = kc * 64 + kh * 32; k < kc * 64 + kh * 32 + 32; ++k) a += pos[k] * w1[(size_t)k * 128 + n];
      float* tmp = (float*)lds;
      tmp[tid] = a;
      __syncthreads();
      if (tid < 128) p.pospart[(size_t)(kv * 32 + kc) * 128 + tid] = tmp[tid] + tmp[tid + 128];
      __syncthreads();
    } else if (it >= 3680) {
      const int j = it - 3680;
      const int kv = j >> 6;
      transpose_tile((kv ? p.cmp_v_w1 : p.cmp_k_w1) + (size_t)l * 2048 * 128, 128, (j & 31) * 64, ((j >> 5) & 1) * 64, 2,
                     p.W1T + (size_t)kv * 128 * 2048, 2048, lds);
    } else {
      const int j = it - 3424;
      const int lane = TID() & 63, w = TID() >> 6;
      const float* g = p.norm_g + l * 1024;
      for (int i = 0; i < 16; ++i) {
        const int tok = j * 64 + w * 16 + i;
        const float* xr = xin + (size_t)tok * 1024;
        float4 v[4];
        float ss = 0.f;
#pragma unroll
        for (int q = 0; q < 4; ++q) {
          v[q] = *(const float4*)(xr + lane * 4 + 256 * q);
          ss += v[q].x * v[q].x + v[q].y * v[q].y + v[q].z * v[q].z + v[q].w * v[q].w;
        }
        ss = wave_sum(ss, lane);
        const float rs = rsqrtf(ss * (1.f / 1024.f) + 1e-6f);
#pragma unroll
        for (int q = 0; q < 4; ++q) {
          const float4 gg = *(const float4*)(g + lane * 4 + 256 * q);
          uint2 o;
          o.x = pk2(v[q].x * rs * gg.x, v[q].y * rs * gg.y);
          o.y = pk2(v[q].z * rs * gg.z, v[q].w * rs * gg.w);
          *(uint2*)(p.xn + (size_t)tok * 1024 + lane * 4 + 256 * q) = o;
        }
      }
    }
  }
}

DI void phase1(const Params& p, char* lds) {
  const int tid = TID(), lane = tid & 63, w = tid >> 6, wm = w >> 1, wn = w & 1, r = lane & 31, h = lane >> 5;
  for (int tile = blockIdx.x; tile < 128 * 51; tile += gridDim.x) {
    const int grp = tile / (32 * 51), rem = tile % (32 * 51);
    const int nt = rem >> 5, mt = grp * 32 + (rem & 31);
    f32x16 acc[2][2];
    zero_acc(acc);
    gemm_mainloop(p.xn + (size_t)mt * 128 * 1024, 1024, p.WinT + (size_t)nt * 128 * 1024, 1024, 1024, lds, acc);
#pragma unroll
    for (int mi = 0; mi < 2; ++mi) {
      const size_t row = (size_t)mt * 128 + wm * 64 + mi * 32 + r;
#pragma unroll
      for (int ni = 0; ni < 2; ++ni) {
#pragma unroll
        for (int a = 0; a < 4; ++a) {
          const int col = nt * 128 + wn * 64 + ni * 32 + 8 * a + 4 * h;
          uint2 o;
          o.x = pk2(acc[mi][ni][4 * a], acc[mi][ni][4 * a + 1]);
          o.y = pk2(acc[mi][ni][4 * a + 2], acc[mi][ni][4 * a + 3]);
          *(uint2*)(p.z + row * ZS + col) = o;
        }
      }
    }
  }
}

DI void phase4(const Params& p, char* lds) {
  const int tid = TID(), lane = tid & 63, w = tid >> 6, wm = w >> 1, wn = w & 1, r = lane & 31, h = lane >> 5;
  for (int tile = blockIdx.x; tile < 128 * 8; tile += gridDim.x) {
    const int nt = tile & 7, mt = tile >> 3;
    f32x16 mg[2][2];
    zero_acc(mg);
#pragma unroll 1
    for (int n = 0; n < 4; ++n) {
      f32x16 acc[2][2];
      zero_acc(acc);
      gemm_mainloop_shallow(p.xn + (size_t)mt * 128 * 1024, 1024, p.WgT + ((size_t)n * 1024 + nt * 128) * 1024, 1024, 1024, lds,
                    acc);
      uint4* scr = p.blkscr + (size_t)blockIdx.x * 8 * 256 + tid;
#pragma unroll
      for (int a = 0; a < 2; ++a)
#pragma unroll
        for (int b = 0; b < 2; ++b)
#pragma unroll
          for (int i = 0; i < 2; ++i) {
            uint4 o;
            o.x = pk2(sigmoidf_(acc[a][b][8 * i]), sigmoidf_(acc[a][b][8 * i + 1]));
            o.y = pk2(sigmoidf_(acc[a][b][8 * i + 2]), sigmoidf_(acc[a][b][8 * i + 3]));
            o.z = pk2(sigmoidf_(acc[a][b][8 * i + 4]), sigmoidf_(acc[a][b][8 * i + 5]));
            o.w = pk2(sigmoidf_(acc[a][b][8 * i + 6]), sigmoidf_(acc[a][b][8 * i + 7]));
            scr[((a * 2 + b) * 2 + i) * 256] = o;
          }
      zero_acc(acc);
      const int yoff = (n == 0) ? GA : ((n == 1) ? GB : ((n == 2) ? GC : GD));
      gemm_mainloop_shallow(p.z + (size_t)mt * 128 * ZS + yoff, ZS, p.WbT + ((size_t)n * 1024 + nt * 128) * 512, 512, 512, lds,
                    acc);
#pragma unroll
      for (int a = 0; a < 2; ++a)
#pragma unroll
        for (int b = 0; b < 2; ++b)
#pragma unroll
          for (int i = 0; i < 2; ++i) {
            const uint4 o = scr[((a * 2 + b) * 2 + i) * 256];
            mg[a][b][8 * i] += bflo(o.x) * acc[a][b][8 * i];
            mg[a][b][8 * i + 1] += bfhi(o.x) * acc[a][b][8 * i + 1];
            mg[a][b][8 * i + 2] += bflo(o.y) * acc[a][b][8 * i + 2];
            mg[a][b][8 * i + 3] += bfhi(o.y) * acc[a][b][8 * i + 3];
            mg[a][b][8 * i + 4] += bflo(o.z) * acc[a][b][8 * i + 4];
            mg[a][b][8 * i + 5] += bfhi(o.z) * acc[a][b][8 * i + 5];
            mg[a][b][8 * i + 6] += bflo(o.w) * acc[a][b][8 * i + 6];
            mg[a][b][8 * i + 7] += bfhi(o.w) * acc[a][b][8 * i + 7];
          }
    }
#pragma unroll
    for (int mi = 0; mi < 2; ++mi) {
      const size_t row = (size_t)mt * 128 + wm * 64 + mi * 32 + r;
#pragma unroll
      for (int ni = 0; ni < 2; ++ni)
#pragma unroll
        for (int a = 0; a < 4; ++a) {
          const int col = nt * 128 + wn * 64 + ni * 32 + 8 * a + 4 * h;
          uint2 o;
          o.x = pk2(mg[mi][ni][4 * a], mg[mi][ni][4 * a + 1]);
          o.y = pk2(mg[mi][ni][4 * a + 2], mg[mi][ni][4 * a + 3]);
          *(uint2*)(p.z + row * ZS + col) = o;
        }
    }
  }
}

DI void phase5(const Params& p, const float* xin, float* xout, char* lds) {
  const int tid = TID(), lane = tid & 63, w = tid >> 6, wm = w >> 1, wn = w & 1, r = lane & 31, h = lane >> 5;
  for (int tile = blockIdx.x; tile < 128 * 8; tile += gridDim.x) {
    const int nt = tile & 7, mt = tile >> 3;
    f32x16 acc[2][2];
    zero_acc(acc);
    gemm_mainloop(p.z + (size_t)mt * 128 * ZS, ZS, p.WoT + (size_t)nt * 128 * 1024, 1024, 1024, lds, acc);
#pragma unroll
    for (int mi = 0; mi < 2; ++mi) {
      const size_t row = (size_t)mt * 128 + wm * 64 + mi * 32 + r;
#pragma unroll
      for (int ni = 0; ni < 2; ++ni)
#pragma unroll
        for (int a = 0; a < 4; ++a) {
          const int col = nt * 128 + wn * 64 + ni * 32 + 8 * a + 4 * h;
          float4 xv = *(const float4*)(xin + row * 1024 + col);
          xv.x += acc[mi][ni][4 * a];
          xv.y += acc[mi][ni][4 * a + 1];
          xv.z += acc[mi][ni][4 * a + 2];
          xv.w += acc[mi][ni][4 * a + 3];
          *(float4*)(xout + row * 1024 + col) = xv;
        }
    }
  }
}

DI void compress_item(const Params& p, int l, int item, char* lds) {
  const int kv = item & 1, half = (item >> 1) & 1, g = (item >> 2) & 1, b = item >> 3;
  const int tid = TID(), lane = tid & 63, w = tid >> 6, wm = w >> 1, wn = w & 1, r = lane & 31, h = lane >> 5;
  const float* w2 = (kv ? p.cmp_v_w2 : p.cmp_k_w2) + (size_t)l * 128 * 64;
  float* posw = (float*)lds;
  {
    if (tid < 128) {
      float a = 0.f;
#pragma unroll 8
      for (int kc = 0; kc < 32; ++kc) a += p.pospart[(size_t)(kv * 32 + kc) * 128 + tid];
      posw[tid] = a;
    }
    __syncthreads();
  }
  float pw[2][16];
#pragma unroll
  for (int ni = 0; ni < 2; ++ni)
#pragma unroll
    for (int i = 0; i < 16; ++i) pw[ni][i] = posw[wn * 64 + ni * 32 + (i & 3) + 8 * (i >> 2) + 4 * h];
  __syncthreads();
  f32x16 acc[2][2];
  zero_acc(acc);
  const u16* Ag = p.z + ((size_t)b * S_ + 16 * (half * 128)) * ZS + (kv ? VCC : KCC) + g * 64;
  gemm_mainloop(Ag, 16 * ZS, p.W1T + (size_t)kv * 128 * 2048, 2048, 2048, lds, acc, ZS);
  float* hid = (float*)lds;
#pragma unroll
  for (int mi = 0; mi < 2; ++mi)
#pragma unroll
    for (int ni = 0; ni < 2; ++ni)
#pragma unroll
      for (int i = 0; i < 16; ++i) {
        const int row = wm * 64 + mi * 32 + r, col = wn * 64 + ni * 32 + (i & 3) + 8 * (i >> 2) + 4 * h;
        hid[row * 132 + col] = siluf_(acc[mi][ni][i] + pw[ni][i]);
      }
  __syncthreads();
  {
    const int e = tid & 63, rq = tid >> 6;
    float o[32];
#pragma unroll
    for (int i = 0; i < 32; ++i) o[i] = 0.f;
    for (int n = 0; n < 128; n += 4) {
      const float w0 = w2[n * 64 + e], w1v = w2[(n + 1) * 64 + e], w2v = w2[(n + 2) * 64 + e], w3 = w2[(n + 3) * 64 + e];
#pragma unroll
      for (int i = 0; i < 32; ++i) {
        const float4 hv = *(const float4*)(hid + (rq * 32 + i) * 132 + n);
        o[i] += hv.x * w0 + hv.y * w1v + hv.z * w2v + hv.w * w3;
      }
    }
    const float gk = p.kn_c[l * 64 + e];
#pragma unroll
    for (int i = 0; i < 32; ++i) {
      const int c = half * 128 + rq * 32 + i;
      float v = o[i];
      if (kv == 0) {
        const float ss = wave_sum(v * v, lane);
        v = v * rsqrtf(ss * (1.f / 64.f) + 1e-6f) * gk;
      }
      if (c >= 255) v = 0.f;
      u16* dst = (kv ? p.vc : p.kc) + ((size_t)(b * 2 + g) * 256 + c) * 64 + e;
      *dst = f2bf(v);
    }
  }
}

DI void lru_item(const Params& p, int l, int item, int pass, char* lds, int dry = 0) {
  const int n = item & 7, chunk = (item >> 3) & 63, b = item >> 9;
  float* xcs = (float*)lds;
  float* segP = xcs + 64 * 64;
  float* segH = segP + 256;
  const int tid = TID(), ch = tid & 63, tq = tid >> 6;
  const int chg = n * 64 + ch;
  const int t0 = chunk * 64 + tq * 16;
  const u16* zb = p.z + (size_t)b * S_ * ZS + XB + chg;
  const float* cw = p.conv_w + l * 4 * 512;
  const float w0 = cw[chg], w1 = cw[512 + chg], w2 = cw[1024 + chg], w3 = cw[1536 + chg];
  const float cb = p.conv_b[l * 512 + chg];
  float xm3 = (t0 >= 3) ? bf2f(zb[(size_t)(t0 - 3) * ZS]) : 0.f;
  float xm2 = (t0 >= 2) ? bf2f(zb[(size_t)(t0 - 2) * ZS]) : 0.f;
  float xm1 = (t0 >= 1) ? bf2f(zb[(size_t)(t0 - 1) * ZS]) : 0.f;
  float xc[16];
#pragma unroll
  for (int i = 0; i < 16; ++i) {
    const float cur = bf2f(zb[(size_t)(t0 + i) * ZS]);
    xc[i] = cb + w0 * xm3 + w1 * xm2 + w2 * xm1 + w3 * cur;
    xm3 = xm2; xm2 = xm1; xm1 = cur;
    xcs[(tq * 16 + i) * 64 + ch] = xc[i];
  }
  __syncthreads();
  float aA[16], aX[16];
#pragma unroll
  for (int i = 0; i < 16; ++i) { aA[i] = 0.f; aX[i] = 0.f; }
  const float* wa = p.w_rg_a + ((size_t)(l * 8 + n) * 64) * 64 + ch;
  const float* wx = p.w_rg_x + ((size_t)(l * 8 + n) * 64) * 64 + ch;
  for (int d = 0; d < 64; d += 4) {
    const float wa0 = wa[d * 64], wa1 = wa[(d + 1) * 64], wa2 = wa[(d + 2) * 64], wa3 = wa[(d + 3) * 64];
    const float wx0 = wx[d * 64], wx1 = wx[(d + 1) * 64], wx2 = wx[(d + 2) * 64], wx3 = wx[(d + 3) * 64];
#pragma unroll
    for (int i = 0; i < 16; ++i) {
      const float4 xv = *(const float4*)(xcs + (tq * 16 + i) * 64 + d);
      aA[i] += xv.x * wa0 + xv.y * wa1 + xv.z * wa2 + xv.w * wa3;
      aX[i] += xv.x * wx0 + xv.y * wx1 + xv.z * wx2 + xv.w * wx3;
    }
  }
  const float ba = p.b_rg_a[l * 512 + chg], bx = p.b_rg_x[l * 512 + chg], lam = p.lru_lambda[l * 512 + chg];
  const float sp = fmaxf(-lam, 0.f) + __logf(1.f + __expf(-fabsf(lam)));
  float P = 1.f, H = 0.f;
#pragma unroll
  for (int i = 0; i < 16; ++i) {
    const float rr = sigmoidf_(aA[i] + ba), ig = sigmoidf_(aX[i] + bx);
    const float la = -8.f * rr * sp;
    const float a = __expf(la);
    const float x2 = 2.f * la;
    const float em = (x2 > -0.1f) ? -x2 * (1.f + x2 * (0.5f + x2 * (0.16666667f + x2 * 0.041666667f))) : 1.f - __expf(x2);
    const float bb = sqrtf(fmaxf(em, 0.f)) * ig * xc[i];
    aA[i] = a; aX[i] = bb;
    H = a * H + bb;
    P *= a;
  }
  segP[tq * 64 + ch] = P;
  segH[tq * 64 + ch] = H;
  __syncthreads();
  if (pass == 1) {
    if (tq == 3) {
      float Pt = 1.f, Ht = 0.f;
#pragma unroll
      for (int s = 0; s < 4; ++s) { Ht = segP[s * 64 + ch] * Ht + segH[s * 64 + ch]; Pt *= segP[s * 64 + ch]; }
      float2 o; o.x = Pt; o.y = Ht;
      *(float2*)(p.lrusum + ((size_t)(b * 64 + chunk) * 512 + chg) * 2) = o;
    }
  } else {
    float hh = 0.f;
    for (int c = 0; c < chunk; ++c) {
      const float2 s = *(const float2*)(p.lrusum + ((size_t)(b * 64 + c) * 512 + chg) * 2);
      hh = s.x * hh + s.y;
    }
    for (int s = 0; s < tq; ++s) hh = segP[s * 64 + ch] * hh + segH[s * 64 + ch];
    u16* zg = p.z + ((size_t)b * S_ + t0) * ZS + GB + chg;
#pragma unroll
    for (int i = 0; i < 16; ++i) {
      hh = aA[i] * hh + aX[i];
      const float gt = bf2f(zg[(size_t)i * ZS]);
      u16* dst = dry ? ((u16*)(p.blkscr + (size_t)blockIdx.x * 8 * 256 + tid) + (i & 7)) : (zg + (size_t)i * ZS);
      *dst = f2bf(hh * siluf_(gt));
    }
  }
}

DI void cumsum_item(const Params& p, int l, int item, char* lds) {
  const int hd = item & 7, b = item >> 3;
  float* part = (float*)lds;
  const int tid = TID();
  const float bfv = p.b_forget[l * 8 + hd];
  const u16* zf = p.z + ((size_t)b * S_ + tid * 16) * ZS + FA + hd;
  float v[16], run = 0.f;
#pragma unroll
  for (int i = 0; i < 16; ++i) {
    const float f = bf2f(zf[(size_t)i * ZS]) + bfv;
    const float ls = fminf(f, 0.f) - __logf(1.f + __expf(-fabsf(f)));
    run += ls;
    v[i] = run;
  }
  part[tid] = run;
  __syncthreads();
  float pre = 0.f;
  for (int i = 0; i < tid; ++i) pre += part[i];
  float* dst = p.cbuf + (size_t)(b * 8 + hd) * S_ + tid * 16;
#pragma unroll
  for (int i = 0; i < 16; ++i) dst[i] = (pre + v[i]) * LOG2E;
}

DI void headnorm_item(const Params& p, int l, int item, int dry = 0) {
  const int tid = TID();
  for (int i = 0; i < 7; ++i) {
    const int vid = tid + 256 * i;
    const int tokl = vid / 28, hv = vid % 28;
    const size_t tok = (size_t)item * 64 + tokl;
    int col; const float* g; float sc = 1.f;
    if (hv < 8) { col = QA + hv * 64; g = p.qn_a + l * 64; sc = QSCALE; }
    else if (hv < 16) { col = KA + (hv - 8) * 64; g = p.kn_a + l * 64; }
    else if (hv < 24) { col = QC + (hv - 16) * 64; g = p.qn_c + l * 64; sc = QSCALE; }
    else if (hv < 26) { col = KSC + (hv - 24) * 64; g = p.kn_c + l * 64; }
    else { col = KWC + (hv - 26) * 64; g = p.kn_c + l * 64; }
    uint4* ptr = (uint4*)(p.z + tok * ZS + col);
    uint4 v[8];
    float ss = 0.f;
#pragma unroll
    for (int q = 0; q < 8; ++q) {
      v[q] = ptr[q];
      const unsigned uu[4] = {v[q].x, v[q].y, v[q].z, v[q].w};
#pragma unroll
      for (int e = 0; e < 4; ++e) { const float a = bflo(uu[e]), c = bfhi(uu[e]); ss += a * a + c * c; }
    }
    const float rs = rsqrtf(ss * (1.f / 64.f) + 1e-6f) * sc;
#pragma unroll
    for (int q = 0; q < 8; ++q) {
      const unsigned uu[4] = {v[q].x, v[q].y, v[q].z, v[q].w};
      unsigned oo[4];
#pragma unroll
      for (int e = 0; e < 4; ++e)
        oo[e] = pk2(bflo(uu[e]) * rs * g[q * 8 + 2 * e], bfhi(uu[e]) * rs * g[q * 8 + 2 * e + 1]);
      uint4* dp = dry ? (p.blkscr + (size_t)blockIdx.x * 8 * 256 + tid + (q & 7) * 256) : (ptr + q);
      *dp = make_uint4(oo[0], oo[1], oo[2], oo[3]);
    }
  }
}

DI void sgprep_item(const Params& p, int l, int item, int dry = 0) {
  const int lane = TID() & 63, w = TID() >> 6;
  const float* g = p.ln_v_g + l * 512 + lane * 8;
  for (int i = 0; i < 16; ++i) {
    const size_t tok = (size_t)item * 64 + w * 16 + i;
    uint4* ptr = (uint4*)(p.z + tok * ZS + VD + lane * 8);
    const uint4 v = *ptr;
    const unsigned uu[4] = {v.x, v.y, v.z, v.w};
    float f[8];
    float s = 0.f;
#pragma unroll
    for (int e = 0; e < 4; ++e) { f[2 * e] = geluf_(bflo(uu[e])); f[2 * e + 1] = geluf_(bfhi(uu[e])); s += f[2 * e] + f[2 * e + 1]; }
    const float mu = wave_sum(s, lane) * (1.f / 512.f);
    float q = 0.f;
#pragma unroll
    for (int e = 0; e < 8; ++e) { f[e] -= mu; q += f[e] * f[e]; }
    const float rs = rsqrtf(wave_sum(q, lane) * (1.f / 512.f) + 1e-6f);
    unsigned oo[4];
#pragma unroll
    for (int e = 0; e < 4; ++e) oo[e] = pk2(f[2 * e] * rs * g[2 * e], f[2 * e + 1] * rs * g[2 * e + 1]);
    uint4* dp = dry ? (p.blkscr + (size_t)blockIdx.x * 8 * 256 + TID()) : ptr;
    *dp = make_uint4(oo[0], oo[1], oo[2], oo[3]);
  }
}

DI void sg_item(const Params& p, int l, int item, char* lds, int dry) {
  const int g = item & 7, chunk = (item >> 3) & 31, b = item >> 8;
  u16* vn = (u16*)lds;
  const int tid = TID(), lane = tid & 63, w = tid >> 6, r = lane & 31, h = lane >> 5;
  const size_t tokbase = (size_t)b * S_ + chunk * 128;
#pragma unroll
  for (int i = 0; i < 4; ++i) {
    const int id = tid + 256 * i, row = id >> 3, c = id & 7;
    *(uint4*)(vn + row * 72 + c * 8) = *(const uint4*)(p.z + (tokbase + row) * ZS + VD + g * 64 + c * 8);
  }
  __syncthreads();
  const int t = 32 * w + r;
  const float* wr = p.w_spatial + (((size_t)(l * 8 + g) * 128) + t) * 128;
  const int q4 = (lane & 15) >> 2, p4 = lane & 3, blk = (lane >> 4) & 1;
  f32x16 acc[2];
#pragma unroll
  for (int i = 0; i < 16; ++i) { acc[0][i] = 0.f; acc[1][i] = 0.f; }
  const int nks = 2 * (w + 1);
  for (int ks = 0; ks < nks; ++ks) {
    const int s0 = ks * 16 + 8 * h;
    const float4 w0 = *(const float4*)(wr + s0);
    const float4 w1 = *(const float4*)(wr + s0 + 4);
    float wv[8] = {w0.x, w0.y, w0.z, w0.w, w1.x, w1.y, w1.z, w1.w};
#pragma unroll
    for (int j = 0; j < 8; ++j) wv[j] = (s0 + j <= t) ? wv[j] : 0.f;
    const uint4 uu = make_uint4(pk2(wv[0], wv[1]), pk2(wv[2], wv[3]), pk2(wv[4], wv[5]), pk2(wv[6], wv[7]));
    const bf16x8 bfr = __builtin_bit_cast(bf16x8, uu);
#pragma unroll
    for (int db = 0; db < 2; ++db) {
      const u16* vp = vn + (ks * 16 + 8 * h + q4) * 72 + db * 32 + 16 * blk + 4 * p4;
      const s16x4 lo = __builtin_amdgcn_ds_read_tr16_b64_v4i16((__attribute__((address_space(3))) s16x4*)(vp));
      const s16x4 hi = __builtin_amdgcn_ds_read_tr16_b64_v4i16((__attribute__((address_space(3))) s16x4*)(vp + 4 * 72));
      const bf16x8 afr = __builtin_shufflevector(lo, hi, 0, 1, 2, 3, 4, 5, 6, 7);
      acc[db] = MFMA(afr, bfr, acc[db]);
    }
  }
  const float bsv = p.b_spatial[(l * 8 + g) * 128 + t];
  u16* zr = p.z + (tokbase + t) * ZS;
#pragma unroll
  for (int db = 0; db < 2; ++db)
#pragma unroll
    for (int a4 = 0; a4 < 4; ++a4) {
      const int d = db * 32 + 8 * a4 + 4 * h;
      const uint2 uv = *(const uint2*)(zr + UD + g * 64 + d);
      uint2* gp = (uint2*)(zr + GD + g * 64 + d);
      const uint2 gv = *gp;
      uint2 o;
      o.x = pk2(geluf_(bflo(uv.x)) * (acc[db][4 * a4] + bsv) * siluf_(bflo(gv.x)),
                geluf_(bfhi(uv.x)) * (acc[db][4 * a4 + 1] + bsv) * siluf_(bfhi(gv.x)));
      o.y = pk2(geluf_(bflo(uv.y)) * (acc[db][4 * a4 + 2] + bsv) * siluf_(bflo(gv.y)),
                geluf_(bfhi(uv.y)) * (acc[db][4 * a4 + 3] + bsv) * siluf_(bfhi(gv.y)));
      if (dry) gp = (uint2*)(p.blkscr + (size_t)blockIdx.x * 8 * 256 + tid + ((db * 4 + a4) >> 1) * 256) + (a4 & 1);
      *gp = o;
    }
}

#define LDK 72
#define OFF_CK 36864
#define OFF_IMP 37376
#define OFF_SEL (OFF_IMP + 64 * 65 * 4)
#define OFF_WUNI (OFF_SEL + 512)
#define OFF_TL (OFF_WUNI + 64)
enum { M_FOX = 0, M_CMP = 1, M_CMP2 = 2, M_SLC = 3, M_WIN = 4 };

template <int MODE>
DI void attn_run(char* lds, const u16* __restrict__ Kg, const u16* __restrict__ Vg, int kstride,
                 const float* __restrict__ cgl, int nt, int first_tile, const bf16x8 (&qf)[2][4], f32x16 (&O)[2][2],
                 float (&m)[2], float (&l)[2], const int (&qpos)[2], const float (&cq)[2], const u64 (&selb)[2],
                 const float (&linv)[2], int wq0) {
  const int tid = TID(), lane = tid & 63, w = tid >> 6, r = lane & 31, h = lane >> 5;
  u16* Ks = (u16*)lds;
  u16* Vs = Ks + 2 * 64 * LDK;
  float* cks = (float*)(lds + OFF_CK);
  float* imp = (float*)(lds + OFF_IMP);
  const int* tlist = (const int*)(lds + OFF_TL);
  uint4 rk0, rk1, rv0 = make_uint4(0, 0, 0, 0), rv1 = make_uint4(0, 0, 0, 0);
  float rc = 0.f;
  const int lrow = tid >> 3, lcc = tid & 7;
  const int q4 = (lane & 15) >> 2, p4 = lane & 3, blk = (lane >> 4) & 1;

#define KEY0_OF(i_) ((MODE == M_SLC) ? tlist[(i_)] * 64 : ((MODE == M_FOX) ? (nt - 1 - (i_)) * 64 : (first_tile + (i_)) * 64))
#define ALOAD(i_)                                                                               \
  {                                                                                             \
    const int k0_ = KEY0_OF(i_);                                                                \
    rk0 = *(const uint4*)(Kg + (size_t)(k0_ + lrow) * kstride + lcc * 8);                       \
    rk1 = *(const uint4*)(Kg + (size_t)(k0_ + lrow + 32) * kstride + lcc * 8);                  \
    if (MODE != M_CMP2) {                                                                       \
      rv0 = *(const uint4*)(Vg + (size_t)(k0_ + lrow) * kstride + lcc * 8);                     \
      rv1 = *(const uint4*)(Vg + (size_t)(k0_ + lrow + 32) * kstride + lcc * 8);                \
    }                                                                                           \
    if (MODE == M_FOX && tid < 64) rc = cgl[k0_ + tid];                                         \
  }
#define ASTORE(b_)                                                                              \
  {                                                                                             \
    *(uint4*)(Ks + (b_) * 64 * LDK + lrow * LDK + lcc * 8) = rk0;                               \
    *(uint4*)(Ks + (b_) * 64 * LDK + (lrow + 32) * LDK + lcc * 8) = rk1;                        \
    if (MODE != M_CMP2) {                                                                       \
      *(uint4*)(Vs + (b_) * 64 * LDK + lrow * LDK + lcc * 8) = rv0;                             \
      *(uint4*)(Vs + (b_) * 64 * LDK + (lrow + 32) * LDK + lcc * 8) = rv1;                      \
    }                                                                                           \
    if (MODE == M_FOX && tid < 64) cks[(b_) * 64 + tid] = rc;                                   \
  }

  ALOAD(0);
  ASTORE(0);
  __syncthreads();
  for (int it = 0; it < nt; ++it) {
    if (it + 1 < nt) ALOAD(it + 1);
    const int key0 = KEY0_OF(it);
    const u16* Kt = Ks + (it & 1) * 64 * LDK;
    const u16* Vt = Vs + (it & 1) * 64 * LDK;
    const float* ckt = cks + (it & 1) * 64;
#pragma unroll 1
    for (int kb = 0; kb < 2; ++kb) {
      const int kbase = key0 + kb * 32;
      bool need = true;
      if (MODE == M_FOX || MODE == M_SLC) need = (kbase <= wq0 + 63);
      if (MODE == M_WIN) need = (kbase <= wq0 + 63) && (kbase + 31 > wq0 - 512);
      if (MODE == M_CMP) need = (16 * kbase + 31 <= wq0 + 63);
      float mainv[2][4], spill[2][4];
      if (need) {
        bool domask = true;
        if (MODE == M_FOX || MODE == M_SLC) domask = (kbase + 31 > wq0);
        if (MODE == M_WIN) domask = (kbase + 31 > wq0) || (kbase <= wq0 + 63 - 512);
        bf16x8 pk[2][2];
#pragma unroll
        for (int nb = 0; nb < 2; ++nb) {
          f32x16 Sn;
          if (MODE == M_FOX) {
#pragma unroll
            for (int a4 = 0; a4 < 4; ++a4) {
              const float4 c4 = *(const float4*)(ckt + kb * 32 + 8 * a4 + 4 * h);
              Sn[4 * a4] = cq[nb] - c4.x; Sn[4 * a4 + 1] = cq[nb] - c4.y; Sn[4 * a4 + 2] = cq[nb] - c4.z; Sn[4 * a4 + 3] = cq[nb] - c4.w;
            }
          } else {
#pragma unroll
            for (int i = 0; i < 16; ++i) Sn[i] = 0.f;
          }
#pragma unroll
          for (int ks = 0; ks < 4; ++ks) {
            const bf16x8 a = *(const bf16x8*)(Kt + (kb * 32 + r) * LDK + ks * 16 + 8 * h);
            Sn = MFMA(a, qf[nb][ks], Sn);
          }
          float sv[16];
          const int t = qpos[nb];
          bool sb = true;
          if (MODE == M_SLC) sb = (((selb[nb] >> (key0 >> 6)) & 1ull) != 0ull);
          if (domask) {
#pragma unroll
            for (int i = 0; i < 16; ++i) {
              const int kk = kbase + (i & 3) + 8 * (i >> 2) + 4 * h;
              bool valid;
              if (MODE == M_FOX) valid = (kk <= t);
              else if (MODE == M_CMP || MODE == M_CMP2) valid = (16 * kk + 31 <= t) && (kk < 255);
              else if (MODE == M_SLC) valid = sb && (kk <= t);
              else valid = (kk <= t) && (kk > t - 512);
              sv[i] = valid ? Sn[i] : -INFINITY;
            }
          } else {
#pragma unroll
            for (int i = 0; i < 16; ++i) sv[i] = (MODE == M_SLC) ? (sb ? Sn[i] : -INFINITY) : Sn[i];
          }
          if (MODE == M_CMP2) {
#pragma unroll
            for (int a4 = 0; a4 < 4; ++a4) {
              float pe[4];
#pragma unroll
              for (int e = 0; e < 4; ++e) pe[e] = __builtin_amdgcn_exp2f(sv[4 * a4 + e] - m[nb]) * linv[nb];
              mainv[nb][a4] = pe[0] + pe[1] + pe[2] + 0.5f * pe[3];
              spill[nb][a4] = 0.5f * pe[3];
            }
          } else {
            float mx = sv[0];
#pragma unroll
            for (int i = 1; i < 16; ++i) mx = fmaxf(mx, sv[i]);
            mx = fmaxf(mx, shx(mx, lane, 32));
            if (__any(mx > m[nb] + 8.f)) {
              const float mnew = (mx > m[nb] + 8.f) ? mx : m[nb];
              const float alpha = __builtin_amdgcn_exp2f(m[nb] - mnew);
              m[nb] = mnew;
              l[nb] *= alpha;
#pragma unroll
              for (int i = 0; i < 16; ++i) { O[0][nb][i] *= alpha; O[1][nb][i] *= alpha; }
            }
            const float mc = m[nb];
            float ps = 0.f;
#pragma unroll
            for (int i = 0; i < 16; ++i) {
              sv[i] = __builtin_amdgcn_exp2f(sv[i] - mc);
              ps += sv[i];
            }
            l[nb] += ps;
#pragma unroll
            for (int s2 = 0; s2 < 2; ++s2) {
              const unsigned u0 = pk2(sv[8 * s2], sv[8 * s2 + 1]), u1 = pk2(sv[8 * s2 + 2], sv[8 * s2 + 3]);
              const unsigned u2 = pk2(sv[8 * s2 + 4], sv[8 * s2 + 5]), u3 = pk2(sv[8 * s2 + 6], sv[8 * s2 + 7]);
              const uint4 uu = make_uint4(u0, u1, u2, u3);
              pk[nb][s2] = __builtin_bit_cast(bf16x8, uu);
            }
          }
        }
        if (MODE != M_CMP2) {
#pragma unroll
          for (int s2 = 0; s2 < 2; ++s2) {
#pragma unroll
            for (int db = 0; db < 2; ++db) {
              const u16* vp = Vt + (kb * 32 + 16 * s2 + 4 * h + q4) * LDK + db * 32 + 16 * blk + 4 * p4;
              const s16x4 lo = __builtin_amdgcn_ds_read_tr16_b64_v4i16((__attribute__((address_space(3))) s16x4*)(vp));
              const s16x4 hi = __builtin_amdgcn_ds_read_tr16_b64_v4i16((__attribute__((address_space(3))) s16x4*)(vp + 8 * LDK));
              const bf16x8 a = __builtin_shufflevector(lo, hi, 0, 1, 2, 3, 4, 5, 6, 7);
              O[db][0] = MFMA(a, pk[0][s2], O[db][0]);
              O[db][1] = MFMA(a, pk[1][s2], O[db][1]);
            }
          }
        }
      }
      if (MODE == M_CMP2) {
        const int jb = (kbase >> 2) + h;
        for (int rr = 0; rr < 4; ++rr) {
          if (w == rr) {
#pragma unroll
            for (int nb = 0; nb < 2; ++nb)
#pragma unroll
              for (int a4 = 0; a4 < 4; ++a4) imp[(nb * 32 + r) * 65 + jb + 2 * a4] += mainv[nb][a4];
#pragma unroll
            for (int nb = 0; nb < 2; ++nb)
#pragma unroll
              for (int a4 = 0; a4 < 4; ++a4) imp[(nb * 32 + r) * 65 + jb + 2 * a4 + 1] += spill[nb][a4];
          }
          __syncthreads();
        }
      }
    }
    if (it + 1 < nt) ASTORE((it + 1) & 1);
    __syncthreads();
  }
#undef KEY0_OF
#undef ALOAD
#undef ASTORE
}

DI void attn_init(f32x16 (&O)[2][2], float (&m)[2], float (&l)[2]) {
#pragma unroll
  for (int a = 0; a < 2; ++a)
#pragma unroll
    for (int b = 0; b < 2; ++b)
#pragma unroll
      for (int i = 0; i < 16; ++i) O[a][b][i] = 0.f;
  m[0] = m[1] = NEGBIG;
  l[0] = l[1] = 0.f;
}

DI void fox_item(const Params& p, int l_, int item, char* lds, int dry) {
  const int qb = 15 - (item >> 5), bh = item & 31, b = bh >> 3, hd = bh & 7;
  const int tid = TID(), lane = tid & 63, w = tid >> 6, r = lane & 31, h = lane >> 5;
  const int wq0 = qb * 256 + w * 64;
  const int qpos[2] = {wq0 + r, wq0 + 32 + r};
  u16* zb = p.z + (size_t)b * S_ * ZS;
  bf16x8 qf[2][4];
#pragma unroll
  for (int nb = 0; nb < 2; ++nb)
#pragma unroll
    for (int ks = 0; ks < 4; ++ks)
      qf[nb][ks] = *(const bf16x8*)(zb + (size_t)qpos[nb] * ZS + QA + hd * 64 + ks * 16 + 8 * h);
  const float* cb = p.cbuf + (size_t)(b * 8 + hd) * S_;
  const float cq[2] = {cb[qpos[0]], cb[qpos[1]]};
  f32x16 O[2][2];
  float m[2], l[2];
  attn_init(O, m, l);
  const u64 selb[2] = {0ull, 0ull};
  const float linv[2] = {0.f, 0.f};
  attn_run<M_FOX>(lds, zb + KA + hd * 64, zb + VA + hd * 64, ZS, cb, 4 * (qb + 1), 0, qf, O, m, l, qpos, cq, selb, linv, wq0);
#pragma unroll
  for (int nb = 0; nb < 2; ++nb) {
    const float lt = l[nb] + shx(l[nb], lane, 32);
    const float inv = (lt > 0.f) ? 1.f / lt : 0.f;
    u16* zr = zb + (size_t)qpos[nb] * ZS + GA + hd * 64;
#pragma unroll
    for (int db = 0; db < 2; ++db)
#pragma unroll
      for (int a4 = 0; a4 < 4; ++a4) {
        uint2* gp = (uint2*)(zr + db * 32 + 8 * a4 + 4 * h);
        const uint2 gv = *gp;
        uint2 o;
        o.x = pk2(O[db][nb][4 * a4] * inv * siluf_(bflo(gv.x)), O[db][nb][4 * a4 + 1] * inv * siluf_(bfhi(gv.x)));
        o.y = pk2(O[db][nb][4 * a4 + 2] * inv * siluf_(bflo(gv.y)), O[db][nb][4 * a4 + 3] * inv * siluf_(bfhi(gv.y)));
        if (dry) gp = (uint2*)(p.blkscr + (size_t)blockIdx.x * 8 * 256 + tid + ((nb * 8 + db * 4 + a4) >> 1) * 256) + (a4 & 1);
        *gp = o;
      }
  }
}

DI void nsa_item(const Params& p, int l_, int item, char* lds, int dry) {
  const int qb = 63 - (item >> 3), bg = item & 7, b = bg >> 1, g = bg & 1;
  const int tid = TID(), lane = tid & 63, w = tid >> 6, r = lane & 31, h = lane >> 5;
  const int head = g * 4 + w;
  float* imp = (float*)(lds + OFF_IMP);
  u64* selm = (u64*)(lds + OFF_SEL);
  u64* wuni = (u64*)(lds + OFF_WUNI);
  int* tlist = (int*)(lds + OFF_TL);
  for (int i = tid; i < 64 * 65; i += 256) imp[i] = 0.f;
  const int wq0 = qb * 64;
  const int qpos[2] = {wq0 + r, wq0 + 32 + r};
  u16* zb = p.z + (size_t)b * S_ * ZS;
  bf16x8 qf[2][4];
#pragma unroll
  for (int nb = 0; nb < 2; ++nb)
#pragma unroll
    for (int ks = 0; ks < 4; ++ks)
      qf[nb][ks] = *(const bf16x8*)(zb + (size_t)qpos[nb] * ZS + QC + head * 64 + ks * 16 + 8 * h);
#define scr (p.blkscr + (size_t)blockIdx.x * 8 * 256 + TID())
#define NSA_GATE(c_, nb_) sigmoidf_(bf2f(zb[(size_t)qpos[nb_] * ZS + GATEC + (c_) * 8 + head]))
  const float cq[2] = {0.f, 0.f};
  u64 selb[2] = {0ull, 0ull};
  float linv[2] = {0.f, 0.f};
  f32x16 O[2][2];
  float m[2], l[2];

  attn_init(O, m, l);
  const u16* kcp = p.kc + (size_t)(b * 2 + g) * 256 * 64;
  const u16* vcp = p.vc + (size_t)(b * 2 + g) * 256 * 64;
  attn_run<M_CMP>(lds, kcp, vcp, 64, nullptr, 4, 0, qf, O, m, l, qpos, cq, selb, linv, wq0);
#pragma unroll
  for (int nb = 0; nb < 2; ++nb) {
    const float lt = l[nb] + shx(l[nb], lane, 32);
    linv[nb] = (lt > 0.f) ? 1.f / lt : 0.f;
    const float sc = linv[nb] * NSA_GATE(0, nb);
#pragma unroll
    for (int db = 0; db < 2; ++db)
#pragma unroll
      for (int i = 0; i < 2; ++i) {
        uint4 o;
        o.x = pk2(O[db][nb][8 * i] * sc, O[db][nb][8 * i + 1] * sc);
        o.y = pk2(O[db][nb][8 * i + 2] * sc, O[db][nb][8 * i + 3] * sc);
        o.z = pk2(O[db][nb][8 * i + 4] * sc, O[db][nb][8 * i + 5] * sc);
        o.w = pk2(O[db][nb][8 * i + 6] * sc, O[db][nb][8 * i + 7] * sc);
        scr[((nb * 2 + db) * 2 + i) * 256] = o;
      }
  }
  attn_run<M_CMP2>(lds, kcp, vcp, 64, nullptr, 4, 0, qf, O, m, l, qpos, cq, selb, linv, wq0);
  {
    u64 uni = 0ull;
    const int j = lane;
    const bool valid = (j <= qb);
    const bool forced = (j == 0) || (valid && j > qb - 2);
    for (int qq = 0; qq < 16; ++qq) {
      const int q = 16 * w + qq;
      const float sc = forced ? 1e6f : (valid ? imp[q * 65 + j] : -1.f);
      int rank = 0;
#pragma unroll
      for (int i = 0; i < 64; ++i) {
        const float si = __int_as_float(__builtin_amdgcn_readlane(__float_as_int(sc), i));
        rank += ((si > sc) || (si == sc && i < j)) ? 1 : 0;
      }
      const bool sel = (rank < 16) && (sc >= 0.f);
      const u64 mk = __ballot(sel);
      if (lane == 0) selm[q] = mk;
      uni |= mk;
    }
    if (lane == 0) wuni[w] = uni;
  }
  __syncthreads();
  const u64 U = wuni[0] | wuni[1] | wuni[2] | wuni[3];
  if (w == 0 && ((U >> lane) & 1ull)) tlist[__popcll(U & ((1ull << lane) - 1ull))] = lane;
  const int ntl = __popcll(U);
  selb[0] = selm[r];
  selb[1] = selm[32 + r];
  __syncthreads();
  attn_init(O, m, l);
  attn_run<M_SLC>(lds, zb + KSC + g * 64, zb + VSC + g * 64, ZS, nullptr, ntl, 0, qf, O, m, l, qpos, cq, selb, linv, wq0);
#pragma unroll
  for (int nb = 0; nb < 2; ++nb) {
    const float lt = l[nb] + shx(l[nb], lane, 32);
    const float sc = ((lt > 0.f) ? 1.f / lt : 0.f) * NSA_GATE(1, nb);
#pragma unroll
    for (int db = 0; db < 2; ++db)
#pragma unroll
      for (int i = 0; i < 2; ++i) {
        uint4 o = scr[((nb * 2 + db) * 2 + i) * 256];
        o.x = pk2(bflo(o.x) + O[db][nb][8 * i] * sc, bfhi(o.x) + O[db][nb][8 * i + 1] * sc);
        o.y = pk2(bflo(o.y) + O[db][nb][8 * i + 2] * sc, bfhi(o.y) + O[db][nb][8 * i + 3] * sc);
        o.z = pk2(bflo(o.z) + O[db][nb][8 * i + 4] * sc, bfhi(o.z) + O[db][nb][8 * i + 5] * sc);
        o.w = pk2(bflo(o.w) + O[db][nb][8 * i + 6] * sc, bfhi(o.w) + O[db][nb][8 * i + 7] * sc);
        scr[((nb * 2 + db) * 2 + i) * 256] = o;
      }
  }
  attn_init(O, m, l);
  const int first = (qb >= 8) ? qb - 8 : 0;
  attn_run<M_WIN>(lds, zb + KWC + g * 64, zb + VWC + g * 64, ZS, nullptr, qb - first + 1, first, qf, O, m, l, qpos, cq, selb, linv, wq0);
#pragma unroll
  for (int nb = 0; nb < 2; ++nb) {
    const float lt = l[nb] + shx(l[nb], lane, 32);
    const float sc = ((lt > 0.f) ? 1.f / lt : 0.f) * NSA_GATE(2, nb);
    u16* zr = zb + (size_t)qpos[nb] * ZS + GC + head * 64;
#pragma unroll
    for (int db = 0; db < 2; ++db)
#pragma unroll
      for (int a4 = 0; a4 < 4; ++a4) {
        uint2* gp = (uint2*)(zr + db * 32 + 8 * a4 + 4 * h);
        const uint2 gv = *gp;
        const uint2 pv = *((const uint2*)&scr[((nb * 2 + db) * 2 + (a4 >> 1)) * 256] + (a4 & 1));
        const unsigned o0 = pv.x, o1 = pv.y;
        uint2 o;
        o.x = pk2((bflo(o0) + O[db][nb][4 * a4] * sc) * siluf_(bflo(gv.x)),
                  (bfhi(o0) + O[db][nb][4 * a4 + 1] * sc) * siluf_(bfhi(gv.x)));
        o.y = pk2((bflo(o1) + O[db][nb][4 * a4 + 2] * sc) * siluf_(bflo(gv.y)),
                  (bfhi(o1) + O[db][nb][4 * a4 + 3] * sc) * siluf_(bfhi(gv.y)));
        if (dry) gp = (uint2*)&scr[((nb * 2 + db) * 2 + (a4 >> 1)) * 256] + (a4 & 1);
        *gp = o;
      }
  }
}

#undef scr
#define XB_TMO      128
#define XB_XCNT(j)  (256  + 64 * (j))
#define XB_XSUB(j)  (1280 + 64 * (j))
#define XB_XGEN(j)  (2304 + 64 * (j))
#define XB_TOP      3328
#define XB_TOPGEN   3392
#define XCD_BAR_WORDS 3456
#define XB_SPIN_CAP (1u << 18)
#define LAS __attribute__((address_space(3)))

__device__ __forceinline__ unsigned xb_ld(unsigned* p)              { return __hip_atomic_load(p, __ATOMIC_RELAXED, __HIP_MEMORY_SCOPE_AGENT); }
__device__ __forceinline__ unsigned xb_add(unsigned* p, unsigned v) { return __hip_atomic_fetch_add(p, v, __ATOMIC_RELAXED, __HIP_MEMORY_SCOPE_AGENT); }
__device__ __forceinline__ unsigned xb_xcc_id() { return (unsigned)__builtin_amdgcn_s_getreg((3 << 11) | 20) & 0xFu; }
#define XB_SPIN(cond, bar) do { unsigned _sp = 0; while (cond) { __builtin_amdgcn_s_sleep(1); \
    if ((++_sp & 255u) == 0u) { if (xb_ld(&(bar)[XB_TMO])) break; if (_sp > XB_SPIN_CAP) { atomicAdd(&(bar)[XB_TMO], 1u); break; } } } } while (0)

struct XcdBarrier {
    unsigned* bar; unsigned x;
    volatile LAS unsigned* st;
};

__device__ __forceinline__ XcdBarrier xcd_barrier_post(unsigned* bar, volatile LAS unsigned* st) {
    XcdBarrier b; b.bar = bar; b.x = xb_xcc_id(); b.st = st;
    if (threadIdx.x == 0) (void)xb_add(&bar[XB_XCNT(b.x)], 1u);
    return b;
}
__device__ __forceinline__ void xcd_barrier_complete(unsigned* bar, unsigned x, unsigned& nloc, unsigned& nx) {
    const unsigned G = gridDim.x * gridDim.y * gridDim.z;
    unsigned sum, cnt, mine, sp = 0u;
    for (;;) {
        sum = 0u; cnt = 0u; mine = 0u;
#pragma unroll
        for (unsigned j = 0; j < 16; ++j) { const unsigned c = xb_ld(&bar[XB_XCNT(j)]); sum += c; cnt += (c > 0u) ? 1u : 0u; mine = (j == x) ? c : mine; }
        if (sum == G) break;
        __builtin_amdgcn_s_sleep(1);
        if ((++sp & 255u) == 0u) { if (xb_ld(&bar[XB_TMO])) break; if (sp > XB_SPIN_CAP) { atomicAdd(&bar[XB_TMO], 1u); break; } }
    }
    nloc = mine > 0u ? mine : 1u; nx = cnt > 0u ? cnt : 1u;
}

__device__ __forceinline__ void xcd_barrier(const XcdBarrier& b) {
    asm volatile("s_waitcnt vmcnt(0)" ::: "memory");
    __syncthreads();
    if (threadIdx.x == 0) {
        unsigned* bar = b.bar;
        __builtin_amdgcn_s_waitcnt(0);
        unsigned nloc = b.st[0], nx = b.st[1];
        if (nloc == 0u) { xcd_barrier_complete(bar, b.x, nloc, nx); b.st[0] = nloc; b.st[1] = nx; }
        const unsigned old = xb_add(&bar[XB_XSUB(b.x)], 1u);
        const unsigned gen = old / nloc;
        if (old + 1u == (gen + 1u) * nloc) {
            __builtin_amdgcn_fence(__ATOMIC_RELEASE, "agent");
            asm volatile("s_waitcnt vmcnt(0)" ::: "memory");
            const unsigned og = xb_add(&bar[XB_TOP], 1u);
            const unsigned tg = og / nx;
            if (og + 1u == (tg + 1u) * nx) xb_add(&bar[XB_TOPGEN], 1u);
            else XB_SPIN(xb_ld(&bar[XB_TOPGEN]) == tg, bar);
            __builtin_amdgcn_fence(__ATOMIC_ACQUIRE, "agent");
            xb_add(&bar[XB_XGEN(b.x)], 1u);
            asm volatile("s_waitcnt vmcnt(0)" ::: "memory");
        } else {
            XB_SPIN(xb_ld(&bar[XB_XGEN(b.x)]) == gen, bar);
            __builtin_amdgcn_fence(__ATOMIC_ACQUIRE, "agent");
            asm volatile("s_waitcnt vmcnt(0)" ::: "memory");
        }
    }
    __syncthreads();
}


__global__ void __launch_bounds__(256, 2) hybrid_fwd(Params p) {
  cg::grid_group grid = cg::this_grid();
  __shared__ __attribute__((aligned(16))) char lds[LDS_BYTES];
  __shared__ int slot;
  __shared__ uint4 xb_words;
  if (threadIdx.x == 0) xb_words = make_uint4(0u, 0u, 0u, 0u);
  __syncthreads();
  const XcdBarrier xb = xcd_barrier_post(p.bar, (volatile LAS unsigned*)&xb_words);
  for (int l = 0; l < 2; ++l) {
    const float* xin = (l == 0) ? p.x : p.out;
    for (int rep = 0; rep < REP_P0; ++rep) phase0(p, l, xin, lds);
    if (l == 0) grid.sync(); else xcd_barrier(xb);
    for (int rep = 0; rep < REP_P1; ++rep) phase1(p, lds);
    xcd_barrier(xb);
    {
      for (int rep = 0; rep < REP_P2; ++rep) {
        int* ctr = p.ctr + l * 2 + rep * 8;
        const int dry = (rep + 1 < REP_P2) ? 1 : 0;
        for (;;) {
          const int it = pop_item(ctr, &slot);
          if (it >= 2624) break;
          if (it < 32) { if (!dry || (P2_MASK & 1)) compress_item(p, l, it, lds); }
          else if (it < 2080) { if (!dry || (P2_MASK & 2)) lru_item(p, l, it - 32, 1, lds); }
          else if (it < 2112) { if (!dry || (P2_MASK & 4)) cumsum_item(p, l, it - 2080, lds); }
          else if (it < 2368) { if (!dry || (P2_MASK & 8)) headnorm_item(p, l, it - 2112, dry); }
          else { if (!dry || (P2_MASK & 16)) sgprep_item(p, l, it - 2368, dry); }
        }
      }
    }
    xcd_barrier(xb);
    {
      for (int rep = 0; rep < REP_P3; ++rep) {
        const int dry = (rep + 1 < REP_P3) ? 1 : 0;
        int* ctr = p.ctr + l * 2 + 1 + rep * 4;
        for (;;) {
          const int it = pop_item(ctr, &slot);
          if (it >= 1024) break;
          if (it < 512) { if (!dry || (P3_MASK & 1)) nsa_item(p, l, it, lds, dry); }
          else { if (!dry || (P3_MASK & 2)) fox_item(p, l, it - 512, lds, dry); }
        }
        int* ctr2 = p.ctr + 32 + l * 2 + rep * 4;
        for (;;) {
          const int it = pop_item(ctr2, &slot);
          if (it >= 3072) break;
          if (it < 2048) { if (!dry || (P3_MASK & 4)) lru_item(p, l, it, 2, lds, dry); }
          else { if (!dry || (P3_MASK & 8)) sg_item(p, l, it - 2048, lds, dry); }
        }
      }
    }
    xcd_barrier(xb);
    for (int rep = 0; rep < REP_P4; ++rep) phase4(p, lds);
    xcd_barrier(xb);
    for (int rep = 0; rep < ((l == 0) ? REP_P5 : 1); ++rep) phase5(p, xin, p.out, lds);
    if (l == 0) xcd_barrier(xb);
  }
}

extern "C" void kernel_launch(void* const* d_in, const int* in_sizes, int n_in, void* d_out, int out_size, void* d_ws,
                              size_t ws_size, hipStream_t stream) {
  static int grid_blocks = 0;
  if (!grid_blocks) {
    int dev = 0, cus = 0, per_cu = 0;
    hipGetDevice(&dev);
    hipDeviceGetAttribute(&cus, hipDeviceAttributeMultiprocessorCount, dev);
    hipOccupancyMaxActiveBlocksPerMultiprocessor(&per_cu, hybrid_fwd, 256, 0);
    if (per_cu > 2) per_cu = 2;
    if (per_cu < 1) per_cu = 1;
    grid_blocks = cus * per_cu;
  }
  Params p{};
  const float** f = (const float**)&p;
  for (int i = 0; i < 25; ++i) f[i] = (const float*)d_in[i];
  p.out = (float*)d_out;
  char* ws = (char*)d_ws;
  size_t off = 0;
  auto take = [&](size_t bytes) { char* r = ws + off; off += (bytes + 255) & ~(size_t)255; return r; };
  p.ctr = (int*)take(256);
  p.bar = (unsigned*)take((size_t)XCD_BAR_WORDS * 4);
  p.z = (u16*)take((size_t)T_ * ZS * 2);
  p.xn = (u16*)take((size_t)T_ * 1024 * 2);
  p.WinT = (u16*)take((size_t)6528 * 1024 * 2);
  p.WgT = (u16*)take((size_t)4096 * 1024 * 2);
  p.WbT = (u16*)take((size_t)4 * 1024 * 512 * 2);
  p.WoT = (u16*)take((size_t)1024 * 1024 * 2);
  p.cbuf = (float*)take((size_t)4 * 8 * S_ * 4);
  p.lrusum = (float*)take((size_t)4 * 64 * 512 * 2 * 4);
  p.kc = (u16*)take((size_t)4 * 2 * 256 * 64 * 2);
  p.vc = (u16*)take((size_t)4 * 2 * 256 * 64 * 2);
  p.W1T = (u16*)take((size_t)2 * 128 * 2048 * 2);
  p.pospart = (float*)take((size_t)2 * 32 * 128 * 4);
  p.blkscr = (uint4*)take((size_t)grid_blocks * 8 * 256 * 16);
  hipMemsetAsync(p.ctr, 0, 256 + (((size_t)XCD_BAR_WORDS * 4 + 255) & ~(size_t)255), stream);
  void* args[] = {&p};
  hipError_t e = hipLaunchCooperativeKernel((void*)hybrid_fwd, dim3(grid_blocks), dim3(256), args, 0, stream);
  if (e != hipSuccess) fprintf(stderr, "cooperative launch failed: %s (grid %d)\n", hipGetErrorString(e), grid_blocks);
}
```

```cpp
#include <hip/hip_runtime.h>
#include <hip/hip_cooperative_groups.h>
#include <cstdio>
namespace cg = cooperative_groups;

typedef unsigned short u16;
typedef unsigned long long u64;
typedef short bf16x8 __attribute__((ext_vector_type(8)));
typedef short s16x4 __attribute__((ext_vector_type(4)));
typedef float f32x16 __attribute__((ext_vector_type(16)));
typedef _Float16 bf2_t __attribute__((ext_vector_type(2)));
typedef _Float16 h16x8 __attribute__((ext_vector_type(8)));
typedef float f2_t __attribute__((ext_vector_type(2)));

#define DI __device__ __forceinline__
#define MFMA(a, b, c) __builtin_amdgcn_mfma_f32_32x32x16_f16(__builtin_bit_cast(h16x8, (a)), __builtin_bit_cast(h16x8, (b)), (c), 0, 0, 0)

#define S_ 4096
#define T_ 16384
#define ZS 6528
#define QA 0
#define KA 512
#define VA 1024
#define GA 1536
#define XB 2048
#define GB 2560
#define QC 3072
#define KCC 3584
#define VCC 3712
#define KSC 3840
#define VSC 3968
#define KWC 4096
#define VWC 4224
#define GC 4352
#define UD 4864
#define VD 5376
#define GD 5888
#define FA 6400
#define GATEC 6408
#define LOG2E 1.4426950408889634f
#define QSCALE (0.125f * LOG2E)
#define NEGBIG (-1e30f)
#define LDS_BYTES 73728
#ifndef REP_P0
#define REP_P0 1
#endif
#ifndef REP_P1
#define REP_P1 1
#endif
#ifndef REP_P2
#define REP_P2 1
#endif
#ifndef P2_MASK
#define P2_MASK 31
#endif
#ifndef REP_P5
#define REP_P5 1
#endif
#ifndef REP_P3
#define REP_P3 1
#endif
#ifndef P3_MASK
#define P3_MASK 15
#endif
#ifndef REP_P4
#define REP_P4 1
#endif

struct Params {
  const float *x, *norm_g, *w_in, *b_forget, *qn_a, *kn_a, *conv_w, *conv_b, *w_rg_a, *b_rg_a, *w_rg_x, *b_rg_x,
      *lru_lambda, *qn_c, *kn_c, *cmp_pos, *cmp_k_w1, *cmp_k_w2, *cmp_v_w1, *cmp_v_w2, *ln_v_g, *w_spatial,
      *b_spatial, *w_branch, *w_out;
  float* out;
  int* ctr;
  u16 *z, *xn, *WinT, *WgT, *WbT, *WoT;
  float *cbuf, *lrusum;
  u16 *kc, *vc;
  uint4* blkscr;
  u16* W1T;
  float* pospart;
  unsigned* bar;
};

DI unsigned pk2(float a, float b) { f2_t v = {a, b}; bf2_t r = __builtin_convertvector(v, bf2_t); return __builtin_bit_cast(unsigned, r); }
DI float bflo(unsigned u) { return (float)__builtin_bit_cast(bf2_t, u)[0]; }
DI float bfhi(unsigned u) { return (float)__builtin_bit_cast(bf2_t, u)[1]; }
DI float bf2f(u16 v) { return (float)__builtin_bit_cast(_Float16, v); }
DI u16 f2bf(float x) { return (u16)(pk2(x, 0.f) & 0xffffu); }
DI float sigmoidf_(float x) { return 1.f / (1.f + __expf(-x)); }
DI float siluf_(float x) { return x / (1.f + __expf(-x)); }
DI float geluf_(float x) { return 0.5f * x * (1.f + erff(x * 0.70710678118654752f)); }
DI float shx(float v, int lane, int mask) {
  return __int_as_float(__builtin_amdgcn_ds_bpermute((lane ^ mask) << 2, __float_as_int(v)));
}
DI float wave_sum(float v, int lane) {
#pragma unroll
  for (int o = 32; o > 0; o >>= 1) v += shx(v, lane, o);
  return v;
}
DI int TID() { int t = threadIdx.x; asm volatile("" : "+v"(t)); return t; }
DI int pop_item(int* ctr, int* slot) {
  __syncthreads();
  if (threadIdx.x == 0) *slot = atomicAdd(ctr, 1);
  __syncthreads();
  return *slot;
}

#define LDT 72
#define GEMM_GL1(P, i_, kt_)                                                                           \
  P##a##i_ = *(const uint4*)(Ag + (size_t)(row0 + 32 * i_) * lda + (size_t)(kt_) * akstep + cc * 8);   \
  P##b##i_ = *(const uint4*)(Bg + (size_t)(row0 + 32 * i_) * ldb + (kt_) * 64 + cc * 8);
#define GEMM_GLOAD(P, kt_) { GEMM_GL1(P, 0, kt_) GEMM_GL1(P, 1, kt_) GEMM_GL1(P, 2, kt_) GEMM_GL1(P, 3, kt_) }
#define GEMM_LS1(P, i_, buf_)                                                                  \
  *(uint4*)(As + (buf_) * 128 * LDT + (row0 + 32 * i_) * LDT + cc * 8) = P##a##i_;              \
  *(uint4*)(Bs + (buf_) * 128 * LDT + (row0 + 32 * i_) * LDT + cc * 8) = P##b##i_;
#define GEMM_LSTORE(P, buf_) { GEMM_LS1(P, 0, buf_) GEMM_LS1(P, 1, buf_) GEMM_LS1(P, 2, buf_) GEMM_LS1(P, 3, buf_) }
#define GEMM_COMPUTE(buf_)                                                                               \
  {                                                                                                      \
    const u16* a_ = As + (buf_) * 128 * LDT + (wm * 64 + r) * LDT + 8 * h;                               \
    const u16* b_ = Bs + (buf_) * 128 * LDT + (wn * 64 + r) * LDT + 8 * h;                               \
    _Pragma("unroll") for (int ks = 0; ks < 4; ++ks) {                                                   \
      const bf16x8 a0 = *(const bf16x8*)(a_ + ks * 16);                                                  \
      const bf16x8 a1 = *(const bf16x8*)(a_ + 32 * LDT + ks * 16);                                       \
      const bf16x8 b0 = *(const bf16x8*)(b_ + ks * 16);                                                  \
      const bf16x8 b1 = *(const bf16x8*)(b_ + 32 * LDT + ks * 16);                                       \
      acc[0][0] = MFMA(b0, a0, acc[0][0]);                                                               \
      acc[0][1] = MFMA(b1, a0, acc[0][1]);                                                               \
      acc[1][0] = MFMA(b0, a1, acc[1][0]);                                                               \
      acc[1][1] = MFMA(b1, a1, acc[1][1]);                                                               \
    }                                                                                                    \
  }
template <bool DEEP>
DI void gemm_mainloop_t(const u16* __restrict__ Ag, int lda, const u16* __restrict__ Bg, int ldb, int K, char* ldsraw,
                        f32x16 (&acc)[2][2], int akstep) {
  const int tid = TID(), lane = tid & 63, w = tid >> 6, wm = w >> 1, wn = w & 1, r = lane & 31, h = lane >> 5;
  u16* As = (u16*)ldsraw;
  u16* Bs = As + 2 * 128 * LDT;
  uint4 xa0, xa1, xa2, xa3, xb0, xb1, xb2, xb3;
  const int nk = K >> 6;
  const int row0 = tid >> 3, cc = tid & 7;
  if (DEEP) {
    uint4 ya0, ya1, ya2, ya3, yb0, yb1, yb2, yb3;
    GEMM_GLOAD(x, 0);
    GEMM_GLOAD(y, 1);
    GEMM_LSTORE(x, 0);
    __syncthreads();
    for (int kt = 0; kt < nk; kt += 2) {
      if (kt + 2 < nk) GEMM_GLOAD(x, kt + 2);
      GEMM_COMPUTE(0);
      GEMM_LSTORE(y, 1);
      __syncthreads();
      if (kt + 3 < nk) GEMM_GLOAD(y, kt + 3);
      GEMM_COMPUTE(1);
      if (kt + 2 < nk) GEMM_LSTORE(x, 0);
      __syncthreads();
    }
  } else {
    GEMM_GLOAD(x, 0);
    GEMM_LSTORE(x, 0);
    __syncthreads();
    for (int kt = 0; kt < nk; kt += 2) {
      GEMM_GLOAD(x, kt + 1);
      GEMM_COMPUTE(0);
      GEMM_LSTORE(x, 1);
      __syncthreads();
      if (kt + 2 < nk) GEMM_GLOAD(x, kt + 2);
      GEMM_COMPUTE(1);
      if (kt + 2 < nk) GEMM_LSTORE(x, 0);
      __syncthreads();
    }
  }
}
DI void gemm_mainloop(const u16* __restrict__ Ag, int lda, const u16* __restrict__ Bg, int ldb, int K, char* ldsraw,
                      f32x16 (&acc)[2][2], int akstep = 64) {
  gemm_mainloop_t<true>(Ag, lda, Bg, ldb, K, ldsraw, acc, akstep);
}
DI void gemm_mainloop_shallow(const u16* __restrict__ Ag, int lda, const u16* __restrict__ Bg, int ldb, int K, char* ldsraw,
                              f32x16 (&acc)[2][2]) {
  gemm_mainloop_t<false>(Ag, lda, Bg, ldb, K, ldsraw, acc, 64);
}

DI void zero_acc(f32x16 (&acc)[2][2]) {
#pragma unroll
  for (int a = 0; a < 2; ++a)
#pragma unroll
    for (int b = 0; b < 2; ++b)
#pragma unroll
      for (int i = 0; i < 16; ++i) acc[a][b][i] = 0.f;
}

DI int win_srccol(int n) {
  if (n < 1536) return n;
  if (n < 4352) return n + 8;
  if (n < 6400) return n + 32;
  if (n < 6408) return 1536 + (n - 6400);
  if (n < 6432) return 4360 + (n - 6408);
  return -1;
}
DI void transpose_tile(const float* __restrict__ src, int sld, int k0, int n0, int kind, u16* __restrict__ dst, int dld,
                       char* ldsraw) {
  float* t = (float*)ldsraw;
  const int tid = TID();
  {
    const int nn = tid & 63, kq = tid >> 6;
    const int n = n0 + nn;
    const int sc = (kind == 0) ? win_srccol(n) : ((kind == 1) ? 6432 + n : n);
#pragma unroll
    for (int i = 0; i < 16; ++i) {
      const int kk = kq * 16 + i;
      t[kk * 65 + nn] = (sc >= 0) ? src[(size_t)(k0 + kk) * sld + sc] : 0.f;
    }
  }
  __syncthreads();
  {
    const int nn = tid >> 2, ks = (tid & 3) * 16;
    unsigned o[8];
#pragma unroll
    for (int i = 0; i < 8; ++i) o[i] = pk2(t[(ks + 2 * i) * 65 + nn], t[(ks + 2 * i + 1) * 65 + nn]);
    uint4* d = (uint4*)(dst + (size_t)(n0 + nn) * dld + k0 + ks);
    d[0] = make_uint4(o[0], o[1], o[2], o[3]);
    d[1] = make_uint4(o[4], o[5], o[6], o[7]);
  }
  __syncthreads();
}

DI void phase0(const Params& p, int l, const float* __restrict__ xin, char* lds) {
  const int NI = 1632 + 1024 + 512 + 256 + 256 + 128 + 64;
  for (int it = blockIdx.x; it < NI; it += gridDim.x) {
    if (it < 1632) {
      transpose_tile(p.w_in + (size_t)l * 1024 * 10528, 10528, (it & 15) * 64, (it >> 4) * 64, 0, p.WinT, 1024, lds);
    } else if (it < 2656) {
      const int j = it - 1632;
      transpose_tile(p.w_in + (size_t)l * 1024 * 10528, 10528, (j & 15) * 64, (j >> 4) * 64, 1, p.WgT, 1024, lds);
    } else if (it < 3168) {
      const int j = it - 2656;
      const int n = j >> 7;
      transpose_tile(p.w_branch + ((size_t)(l * 4 + n) * 512) * 1024, 1024, (j & 7) * 64, ((j >> 3) & 15) * 64, 2,
                     p.WbT + (size_t)n * 1024 * 512, 512, lds);
    } else if (it < 3424) {
      const int j = it - 3168;
      transpose_tile(p.w_out + (size_t)l * 1024 * 1024, 1024, (j & 15) * 64, (j >> 4) * 64, 2, p.WoT, 1024, lds);
    } else if (it >= 3808) {
      const int j = it - 3808, kv = j >> 5, kc = j & 31;
      const int tid = TID(), n = tid & 127, kh = tid >> 7;
      const float* w1 = (kv ? p.cmp_v_w1 : p.cmp_k_w1) + (size_t)l * 2048 * 128;
      const float* pos = p.cmp_pos + l * 2048;
      float a = 0.f;
#pragma unroll 8
      for (int k = kc * 64 + kh * 32; k < kc * 64 + kh * 32 + 32; ++k) a += pos[k] * w1[(size_t)k * 128 + n];
      float* tmp = (float*)lds;
      tmp[tid] = a;
      __syncthreads();
      if (tid < 128) p.pospart[(size_t)(kv * 32 + kc) * 128 + tid] = tmp[tid] + tmp[tid + 128];
      __syncthreads();
    } else if (it >= 3680) {
      const int j = it - 3680;
      const int kv = j >> 6;
      transpose_tile((kv ? p.cmp_v_w1 : p.cmp_k_w1) + (size_t)l * 2048 * 128, 128, (j & 31) * 64, ((j >> 5) & 1) * 64, 2,
                     p.W1T + (size_t)kv * 128 * 2048, 2048, lds);
    } else {
      const int j = it - 3424;
      const int lane = TID() & 63, w = TID() >> 6;
      const float* g = p.norm_g + l * 1024;
      for (int i = 0; i < 16; ++i) {
        const int tok = j * 64 + w * 16 + i;
        const float* xr = xin + (size_t)tok * 1024;
        float4 v[4];
        float ss = 0.f;
#pragma unroll
        for (int q = 0; q < 4; ++q) {
          v[q] = *(const float4*)(xr + lane * 4 + 256 * q);
          ss += v[q].x * v[q].x + v[q].y * v[q].y + v[q].z * v[q].z + v[q].w * v[q].w;
        }
        ss = wave_sum(ss, lane);
        const float rs = rsqrtf(ss * (1.f / 1024.f) + 1e-6f);
#pragma unroll
        for (int q = 0; q < 4; ++q) {
          const float4 gg = *(const float4*)(g + lane * 4 + 256 * q);
          uint2 o;
          o.x = pk2(v[q].x * rs * gg.x, v[q].y * rs * gg.y);
          o.y = pk2(v[q].z * rs * gg.z, v[q].w * rs * gg.w);
          *(uint2*)(p.xn + (size_t)tok * 1024 + lane * 4 + 256 * q) = o;
        }
      }
    }
  }
}

DI void phase1(const Params& p, char* lds) {
  const int tid = TID(), lane = tid & 63, w = tid >> 6, wm = w >> 1, wn = w & 1, r = lane & 31, h = lane >> 5;
  for (int tile = blockIdx.x; tile < 128 * 51; tile += gridDim.x) {
    const int grp = tile / (32 * 51), rem = tile % (32 * 51);
    const int nt = rem >> 5, mt = grp * 32 + (rem & 31);
    f32x16 acc[2][2];
    zero_acc(acc);
    gemm_mainloop(p.xn + (size_t)mt * 128 * 1024, 1024, p.WinT + (size_t)nt * 128 * 1024, 1024, 1024, lds, acc);
#pragma unroll
    for (int mi = 0; mi < 2; ++mi) {
      const size_t row = (size_t)mt * 128 + wm * 64 + mi * 32 + r;
#pragma unroll
      for (int ni = 0; ni < 2; ++ni) {
#pragma unroll
        for (int a = 0; a < 4; ++a) {
          const int col = nt * 128 + wn * 64 + ni * 32 + 8 * a + 4 * h;
          uint2 o;
          o.x = pk2(acc[mi][ni][4 * a], acc[mi][ni][4 * a + 1]);
          o.y = pk2(acc[mi][ni][4 * a + 2], acc[mi][ni][4 * a + 3]);
          *(uint2*)(p.z + row * ZS + col) = o;
        }
      }
    }
  }
}

DI void phase4(const Params& p, char* lds) {
  const int tid = TID(), lane = tid & 63, w = tid >> 6, wm = w >> 1, wn = w & 1, r = lane & 31, h = lane >> 5;
  for (int tile = blockIdx.x; tile < 128 * 8; tile += gridDim.x) {
    const int nt = tile & 7, mt = tile >> 3;
    f32x16 mg[2][2];
    zero_acc(mg);
#pragma unroll 1
    for (int n = 0; n < 4; ++n) {
      f32x16 acc[2][2];
      zero_acc(acc);
      gemm_mainloop_shallow(p.xn + (size_t)mt * 128 * 1024, 1024, p.WgT + ((size_t)n * 1024 + nt * 128) * 1024, 1024, 1024, lds,
                    acc);
      uint4* scr = p.blkscr + (size_t)blockIdx.x * 8 * 256 + tid;
#pragma unroll
      for (int a = 0; a < 2; ++a)
#pragma unroll
        for (int b = 0; b < 2; ++b)
#pragma unroll
          for (int i = 0; i < 2; ++i) {
            uint4 o;
            o.x = pk2(sigmoidf_(acc[a][b][8 * i]), sigmoidf_(acc[a][b][8 * i + 1]));
            o.y = pk2(sigmoidf_(acc[a][b][8 * i + 2]), sigmoidf_(acc[a][b][8 * i + 3]));
            o.z = pk2(sigmoidf_(acc[a][b][8 * i + 4]), sigmoidf_(acc[a][b][8 * i + 5]));
            o.w = pk2(sigmoidf_(acc[a][b][8 * i + 6]), sigmoidf_(acc[a][b][8 * i + 7]));
            scr[((a * 2 + b) * 2 + i) * 256] = o;
          }
      zero_acc(acc);
      const int yoff = (n == 0) ? GA : ((n == 1) ? GB : ((n == 2) ? GC : GD));
      gemm_mainloop_shallow(p.z + (size_t)mt * 128 * ZS + yoff, ZS, p.WbT + ((size_t)n * 1024 + nt * 128) * 512, 512, 512, lds,
                    acc);
#pragma unroll
      for (int a = 0; a < 2; ++a)
#pragma unroll
        for (int b = 0; b < 2; ++b)
#pragma unroll
          for (int i = 0; i < 2; ++i) {
            const uint4 o = scr[((a * 2 + b) * 2 + i) * 256];
            mg[a][b][8 * i] += bflo(o.x) * acc[a][b][8 * i];
            mg[a][b][8 * i + 1] += bfhi(o.x) * acc[a][b][8 * i + 1];
            mg[a][b][8 * i + 2] += bflo(o.y) * acc[a][b][8 * i + 2];
            mg[a][b][8 * i + 3] += bfhi(o.y) * acc[a][b][8 * i + 3];
            mg[a][b][8 * i + 4] += bflo(o.z) * acc[a][b][8 * i + 4];
            mg[a][b][8 * i + 5] += bfhi(o.z) * acc[a][b][8 * i + 5];
            mg[a][b][8 * i + 6] += bflo(o.w) * acc[a][b][8 * i + 6];
            mg[a][b][8 * i + 7] += bfhi(o.w) * acc[a][b][8 * i + 7];
          }
    }
#pragma unroll
    for (int mi = 0; mi < 2; ++mi) {
      const size_t row = (size_t)mt * 128 + wm * 64 + mi * 32 + r;
#pragma unroll
      for (int ni = 0; ni < 2; ++ni)
#pragma unroll
        for (int a = 0; a < 4; ++a) {
          const int col = nt * 128 + wn * 64 + ni * 32 + 8 * a + 4 * h;
          uint2 o;
          o.x = pk2(mg[mi][ni][4 * a], mg[mi][ni][4 * a + 1]);
          o.y = pk2(mg[mi][ni][4 * a + 2], mg[mi][ni][4 * a + 3]);
          *(uint2*)(p.z + row * ZS + col) = o;
        }
    }
  }
}

DI void phase5(const Params& p, const float* xin, float* xout, char* lds) {
  const int tid = TID(), lane = tid & 63, w = tid >> 6, wm = w >> 1, wn = w & 1, r = lane & 31, h = lane >> 5;
  for (int tile = blockIdx.x; tile < 128 * 8; tile += gridDim.x) {
    const int nt = tile & 7, mt = tile >> 3;
    f32x16 acc[2][2];
    zero_acc(acc);
    gemm_mainloop(p.z + (size_t)mt * 128 * ZS, ZS, p.WoT + (size_t)nt * 128 * 1024, 1024, 1024, lds, acc);
#pragma unroll
    for (int mi = 0; mi < 2; ++mi) {
      const size_t row = (size_t)mt * 128 + wm * 64 + mi * 32 + r;
#pragma unroll
      for (int ni = 0; ni < 2; ++ni)
#pragma unroll
        for (int a = 0; a < 4; ++a) {
          const int col = nt * 128 + wn * 64 + ni * 32 + 8 * a + 4 * h;
          float4 xv = *(const float4*)(xin + row * 1024 + col);
          xv.x += acc[mi][ni][4 * a];
          xv.y += acc[mi][ni][4 * a + 1];
          xv.z += acc[mi][ni][4 * a + 2];
          xv.w += acc[mi][ni][4 * a + 3];
          *(float4*)(xout + row * 1024 + col) = xv;
        }
    }
  }
}

DI void compress_item(const Params& p, int l, int item, char* lds) {
  const int kv = item & 1, half = (item >> 1) & 1, g = (item >> 2) & 1, b = item >> 3;
  const int tid = TID(), lane = tid & 63, w = tid >> 6, wm = w >> 1, wn = w & 1, r = lane & 31, h = lane >> 5;
  const float* w2 = (kv ? p.cmp_v_w2 : p.cmp_k_w2) + (size_t)l * 128 * 64;
  float* posw = (float*)lds;
  {
    if (tid < 128) {
      float a = 0.f;
#pragma unroll 8
      for (int kc = 0; kc < 32; ++kc) a += p.pospart[(size_t)(kv * 32 + kc) * 128 + tid];
      posw[tid] = a;
    }
    __syncthreads();
  }
  float pw[2][16];
#pragma unroll
  for (int ni = 0; ni < 2; ++ni)
#pragma unroll
    for (int i = 0; i < 16; ++i) pw[ni][i] = posw[wn * 64 + ni * 32 + (i & 3) + 8 * (i >> 2) + 4 * h];
  __syncthreads();
  f32x16 acc[2][2];
  zero_acc(acc);
  const u16* Ag = p.z + ((size_t)b * S_ + 16 * (half * 128)) * ZS + (kv ? VCC : KCC) + g * 64;
  gemm_mainloop(Ag, 16 * ZS, p.W1T + (size_t)kv * 128 * 2048, 2048, 2048, lds, acc, ZS);
  float* hid = (float*)lds;
#pragma unroll
  for (int mi = 0; mi < 2; ++mi)
#pragma unroll
    for (int ni = 0; ni < 2; ++ni)
#pragma unroll
      for (int i = 0; i < 16; ++i) {
        const int row = wm * 64 + mi * 32 + r, col = wn * 64 + ni * 32 + (i & 3) + 8 * (i >> 2) + 4 * h;
        hid[row * 132 + col] = siluf_(acc[mi][ni][i] + pw[ni][i]);
      }
  __syncthreads();
  {
    const int e = tid & 63, rq = tid >> 6;
    float o[32];
#pragma unroll
    for (int i = 0; i < 32; ++i) o[i] = 0.f;
    for (int n = 0; n < 128; n += 4) {
      const float w0 = w2[n * 64 + e], w1v = w2[(n + 1) * 64 + e], w2v = w2[(n + 2) * 64 + e], w3 = w2[(n + 3) * 64 + e];
#pragma unroll
      for (int i = 0; i < 32; ++i) {
        const float4 hv = *(const float4*)(hid + (rq * 32 + i) * 132 + n);
        o[i] += hv.x * w0 + hv.y * w1v + hv.z * w2v + hv.w * w3;
      }
    }
    const float gk = p.kn_c[l * 64 + e];
#pragma unroll
    for (int i = 0; i < 32; ++i) {
      const int c = half * 128 + rq * 32 + i;
      float v = o[i];
      if (kv == 0) {
        const float ss = wave_sum(v * v, lane);
        v = v * rsqrtf(ss * (1.f / 64.f) + 1e-6f) * gk;
      }
      if (c >= 255) v = 0.f;
      u16* dst = (kv ? p.vc : p.kc) + ((size_t)(b * 2 + g) * 256 + c) * 64 + e;
      *dst = f2bf(v);
    }
  }
}

DI void lru_item(const Params& p, int l, int item, int pass, char* lds, int dry = 0) {
  const int n = item & 7, chunk = (item >> 3) & 63, b = item >> 9;
  u16* X = (u16*)lds;
  u16* Wa = X + 64 * 72;
  u16* Wx = Wa + 64 * 72;
  float* preA = (float*)(lds + 3 * 64 * 72 * 2);
  float* preX = preA + 64 * 64;
  float* segP = preX + 64 * 64;
  float* segH = segP + 256;
  float* carA = segH + 256;
  float* carB = carA + 256;
  const int tid = TID(), ch = tid & 63, tq = tid >> 6;
  const int chg = n * 64 + ch;
  const int t0 = chunk * 64 + tq * 16;
  const u16* zb = p.z + (size_t)b * S_ * ZS + XB + chg;
  const float* cw = p.conv_w + l * 4 * 512;
  const float w0 = cw[chg], w1 = cw[512 + chg], w2 = cw[1024 + chg], w3 = cw[1536 + chg];
  const float cb = p.conv_b[l * 512 + chg];
  float xm3 = (t0 >= 3) ? bf2f(zb[(size_t)(t0 - 3) * ZS]) : 0.f;
  float xm2 = (t0 >= 2) ? bf2f(zb[(size_t)(t0 - 2) * ZS]) : 0.f;
  float xm1 = (t0 >= 1) ? bf2f(zb[(size_t)(t0 - 1) * ZS]) : 0.f;
  float xc[16];
#pragma unroll
  for (int i = 0; i < 16; ++i) {
    const float cur = bf2f(zb[(size_t)(t0 + i) * ZS]);
    xc[i] = cb + w0 * xm3 + w1 * xm2 + w2 * xm1 + w3 * cur;
    xm3 = xm2; xm2 = xm1; xm1 = cur;
    X[(tq * 16 + i) * 72 + ch] = f2bf(xc[i]);
  }
  {
    const float4* ga = (const float4*)(p.w_rg_a + ((size_t)(l * 8 + n) * 64) * 64);
    const float4* gx = (const float4*)(p.w_rg_x + ((size_t)(l * 8 + n) * 64) * 64);
#pragma unroll
    for (int i = 0; i < 4; ++i) {
      const int idx = tid + 256 * i, d = idx >> 4, e = (idx & 15) * 4;
      const float4 va = ga[idx], vx = gx[idx];
      uint2 oa, ox;
      oa.x = pk2(va.x, va.y); oa.y = pk2(va.z, va.w);
      ox.x = pk2(vx.x, vx.y); ox.y = pk2(vx.z, vx.w);
      *(uint2*)(Wa + d * 72 + e) = oa;
      *(uint2*)(Wx + d * 72 + e) = ox;
    }
  }
  __syncthreads();
  {
    const int lane = tid & 63, r = lane & 31, h = lane >> 5, mt = tq >> 1, nt = tq & 1;
    const int q4 = (lane & 15) >> 2, p4 = lane & 3, blk = (lane >> 4) & 1;
    f32x16 accA, accX;
#pragma unroll
    for (int i = 0; i < 16; ++i) { accA[i] = 0.f; accX[i] = 0.f; }
#pragma unroll
    for (int ks = 0; ks < 4; ++ks) {
      const bf16x8 af = *(const bf16x8*)(X + (mt * 32 + r) * 72 + ks * 16 + 8 * h);
      const int woff = (ks * 16 + 8 * h + q4) * 72 + nt * 32 + 16 * blk + 4 * p4;
      const s16x4 alo = __builtin_amdgcn_ds_read_tr16_b64_v4i16((__attribute__((address_space(3))) s16x4*)(Wa + woff));
      const s16x4 ahi = __builtin_amdgcn_ds_read_tr16_b64_v4i16((__attribute__((address_space(3))) s16x4*)(Wa + woff + 4 * 72));
      const s16x4 xlo = __builtin_amdgcn_ds_read_tr16_b64_v4i16((__attribute__((address_space(3))) s16x4*)(Wx + woff));
      const s16x4 xhi = __builtin_amdgcn_ds_read_tr16_b64_v4i16((__attribute__((address_space(3))) s16x4*)(Wx + woff + 4 * 72));
      const bf16x8 ba_ = __builtin_shufflevector(alo, ahi, 0, 1, 2, 3, 4, 5, 6, 7);
      const bf16x8 bx_ = __builtin_shufflevector(xlo, xhi, 0, 1, 2, 3, 4, 5, 6, 7);
      accA = MFMA(af, ba_, accA);
      accX = MFMA(af, bx_, accX);
    }
#pragma unroll
    for (int i = 0; i < 16; ++i) {
      const int t = mt * 32 + (i & 3) + 8 * (i >> 2) + 4 * h;
      preA[t * 64 + nt * 32 + r] = accA[i];
      preX[t * 64 + nt * 32 + r] = accX[i];
    }
  }
  __syncthreads();
  float aA[16], aX[16];
#pragma unroll
  for (int i = 0; i < 16; ++i) { aA[i] = preA[(tq * 16 + i) * 64 + ch]; aX[i] = preX[(tq * 16 + i) * 64 + ch]; }
  const float ba = p.b_rg_a[l * 512 + chg], bx = p.b_rg_x[l * 512 + chg], lam = p.lru_lambda[l * 512 + chg];
  const float sp = fmaxf(-lam, 0.f) + __logf(1.f + __expf(-fabsf(lam)));
  float P = 1.f, H = 0.f;
#pragma unroll
  for (int i = 0; i < 16; ++i) {
    const float rr = sigmoidf_(aA[i] + ba), ig = sigmoidf_(aX[i] + bx);
    const float la = -8.f * rr * sp;
    const float a = __expf(la);
    const float x2 = 2.f * la;
    const float em = (x2 > -0.1f) ? -x2 * (1.f + x2 * (0.5f + x2 * (0.16666667f + x2 * 0.041666667f))) : 1.f - __expf(x2);
    const float bb = sqrtf(fmaxf(em, 0.f)) * ig * xc[i];
    aA[i] = a; aX[i] = bb;
    H = a * H + bb;
    P *= a;
  }
  segP[tq * 64 + ch] = P;
  segH[tq * 64 + ch] = H;
  __syncthreads();
  if (pass == 1) {
    if (tq == 3) {
      float Pt = 1.f, Ht = 0.f;
#pragma unroll
      for (int s = 0; s < 4; ++s) { Ht = segP[s * 64 + ch] * Ht + segH[s * 64 + ch]; Pt *= segP[s * 64 + ch]; }
      float2 o; o.x = Pt; o.y = Ht;
      *(float2*)(p.lrusum + ((size_t)(b * 64 + chunk) * 512 + chg) * 2) = o;
    }
  } else {
    {
      const int lo = (chunk * tq) >> 2, hi = (chunk * (tq + 1)) >> 2;
      float cA = 1.f, cB = 0.f;
#pragma unroll 4
      for (int c = lo; c < hi; ++c) {
        const float2 sm = *(const float2*)(p.lrusum + ((size_t)(b * 64 + c) * 512 + chg) * 2);
        cB = sm.x * cB + sm.y;
        cA *= sm.x;
      }
      carA[tq * 64 + ch] = cA;
      carB[tq * 64 + ch] = cB;
    }
    __syncthreads();
    float hh = 0.f;
#pragma unroll
    for (int s = 0; s < 4; ++s) hh = carA[s * 64 + ch] * hh + carB[s * 64 + ch];
    for (int s = 0; s < tq; ++s) hh = segP[s * 64 + ch] * hh + segH[s * 64 + ch];
    u16* zg = p.z + ((size_t)b * S_ + t0) * ZS + GB + chg;
#pragma unroll
    for (int i = 0; i < 16; ++i) {
      hh = aA[i] * hh + aX[i];
      const float gt = bf2f(zg[(size_t)i * ZS]);
      u16* dst = dry ? ((u16*)(p.blkscr + (size_t)blockIdx.x * 8 * 256 + tid) + (i & 7)) : (zg + (size_t)i * ZS);
      *dst = f2bf(hh * siluf_(gt));
    }
  }
}

DI void cumsum_item(const Params& p, int l, int item, char* lds) {
  const int hd = item & 7, b = item >> 3;
  float* part = (float*)lds;
  const int tid = TID();
  const float bfv = p.b_forget[l * 8 + hd];
  const u16* zf = p.z + ((size_t)b * S_ + tid * 16) * ZS + FA + hd;
  float v[16], run = 0.f;
#pragma unroll
  for (int i = 0; i < 16; ++i) {
    const float f = bf2f(zf[(size_t)i * ZS]) + bfv;
    const float ls = fminf(f, 0.f) - __logf(1.f + __expf(-fabsf(f)));
    run += ls;
    v[i] = run;
  }
  part[tid] = run;
  __syncthreads();
  float pre = 0.f;
  for (int i = 0; i < tid; ++i) pre += part[i];
  float* dst = p.cbuf + (size_t)(b * 8 + hd) * S_ + tid * 16;
#pragma unroll
  for (int i = 0; i < 16; ++i) dst[i] = (pre + v[i]) * LOG2E;
}

DI void headnorm_item(const Params& p, int l, int item, int dry = 0) {
  const int tid = TID();
  for (int i = 0; i < 7; ++i) {
    const int vid = tid + 256 * i;
    const int tokl = vid / 28, hv = vid % 28;
    const size_t tok = (size_t)item * 64 + tokl;
    int col; const float* g; float sc = 1.f;
    if (hv < 8) { col = QA + hv * 64; g = p.qn_a + l * 64; sc = QSCALE; }
    else if (hv < 16) { col = KA + (hv - 8) * 64; g = p.kn_a + l * 64; }
    else if (hv < 24) { col = QC + (hv - 16) * 64; g = p.qn_c + l * 64; sc = QSCALE; }
    else if (hv < 26) { col = KSC + (hv - 24) * 64; g = p.kn_c + l * 64; }
    else { col = KWC + (hv - 26) * 64; g = p.kn_c + l * 64; }
    uint4* ptr = (uint4*)(p.z + tok * ZS + col);
    uint4 v[8];
    float ss = 0.f;
#pragma unroll
    for (int q = 0; q < 8; ++q) {
      v[q] = ptr[q];
      const unsigned uu[4] = {v[q].x, v[q].y, v[q].z, v[q].w};
#pragma unroll
      for (int e = 0; e < 4; ++e) { const float a = bflo(uu[e]), c = bfhi(uu[e]); ss += a * a + c * c; }
    }
    const float rs = rsqrtf(ss * (1.f / 64.f) + 1e-6f) * sc;
#pragma unroll
    for (int q = 0; q < 8; ++q) {
      const unsigned uu[4] = {v[q].x, v[q].y, v[q].z, v[q].w};
      unsigned oo[4];
#pragma unroll
      for (int e = 0; e < 4; ++e)
        oo[e] = pk2(bflo(uu[e]) * rs * g[q * 8 + 2 * e], bfhi(uu[e]) * rs * g[q * 8 + 2 * e + 1]);
      uint4* dp = dry ? (p.blkscr + (size_t)blockIdx.x * 8 * 256 + tid + (q & 7) * 256) : (ptr + q);
      *dp = make_uint4(oo[0], oo[1], oo[2], oo[3]);
    }
  }
}

DI void sgprep_item(const Params& p, int l, int item, int dry = 0) {
  const int lane = TID() & 63, w = TID() >> 6;
  const float* g = p.ln_v_g + l * 512 + lane * 8;
  for (int i = 0; i < 16; ++i) {
    const size_t tok = (size_t)item * 64 + w * 16 + i;
    uint4* ptr = (uint4*)(p.z + tok * ZS + VD + lane * 8);
    const uint4 v = *ptr;
    const unsigned uu[4] = {v.x, v.y, v.z, v.w};
    float f[8];
    float s = 0.f;
#pragma unroll
    for (int e = 0; e < 4; ++e) { f[2 * e] = geluf_(bflo(uu[e])); f[2 * e + 1] = geluf_(bfhi(uu[e])); s += f[2 * e] + f[2 * e + 1]; }
    const float mu = wave_sum(s, lane) * (1.f / 512.f);
    float q = 0.f;
#pragma unroll
    for (int e = 0; e < 8; ++e) { f[e] -= mu; q += f[e] * f[e]; }
    const float rs = rsqrtf(wave_sum(q, lane) * (1.f / 512.f) + 1e-6f);
    unsigned oo[4];
#pragma unroll
    for (int e = 0; e < 4; ++e) oo[e] = pk2(f[2 * e] * rs * g[2 * e], f[2 * e + 1] * rs * g[2 * e + 1]);
    uint4* dp = dry ? (p.blkscr + (size_t)blockIdx.x * 8 * 256 + TID()) : ptr;
    *dp = make_uint4(oo[0], oo[1], oo[2], oo[3]);
  }
}

DI void sg_item(const Params& p, int l, int item, char* lds, int dry) {
  const int g = item & 7, chunk = (item >> 3) & 31, b = item >> 8;
  u16* vn = (u16*)lds;
  const int tid = TID(), lane = tid & 63, w = tid >> 6, r = lane & 31, h = lane >> 5;
  const size_t tokbase = (size_t)b * S_ + chunk * 128;
#pragma unroll
  for (int i = 0; i < 4; ++i) {
    const int id = tid + 256 * i, row = id >> 3, c = id & 7;
    *(uint4*)(vn + row * 72 + c * 8) = *(const uint4*)(p.z + (tokbase + row) * ZS + VD + g * 64 + c * 8);
  }
  __syncthreads();
  const int t = 32 * w + r;
  const float* wr = p.w_spatial + (((size_t)(l * 8 + g) * 128) + t) * 128;
  const int q4 = (lane & 15) >> 2, p4 = lane & 3, blk = (lane >> 4) & 1;
  f32x16 acc[2];
#pragma unroll
  for (int i = 0; i < 16; ++i) { acc[0][i] = 0.f; acc[1][i] = 0.f; }
  const int nks = 2 * (w + 1);
  for (int ks = 0; ks < nks; ++ks) {
    const int s0 = ks * 16 + 8 * h;
    const float4 w0 = *(const float4*)(wr + s0);
    const float4 w1 = *(const float4*)(wr + s0 + 4);
    float wv[8] = {w0.x, w0.y, w0.z, w0.w, w1.x, w1.y, w1.z, w1.w};
#pragma unroll
    for (int j = 0; j < 8; ++j) wv[j] = (s0 + j <= t) ? wv[j] : 0.f;
    const uint4 uu = make_uint4(pk2(wv[0], wv[1]), pk2(wv[2], wv[3]), pk2(wv[4], wv[5]), pk2(wv[6], wv[7]));
    const bf16x8 bfr = __builtin_bit_cast(bf16x8, uu);
#pragma unroll
    for (int db = 0; db < 2; ++db) {
      const u16* vp = vn + (ks * 16 + 8 * h + q4) * 72 + db * 32 + 16 * blk + 4 * p4;
      const s16x4 lo = __builtin_amdgcn_ds_read_tr16_b64_v4i16((__attribute__((address_space(3))) s16x4*)(vp));
      const s16x4 hi = __builtin_amdgcn_ds_read_tr16_b64_v4i16((__attribute__((address_space(3))) s16x4*)(vp + 4 * 72));
      const bf16x8 afr = __builtin_shufflevector(lo, hi, 0, 1, 2, 3, 4, 5, 6, 7);
      acc[db] = MFMA(afr, bfr, acc[db]);
    }
  }
  const float bsv = p.b_spatial[(l * 8 + g) * 128 + t];
  u16* zr = p.z + (tokbase + t) * ZS;
#pragma unroll
  for (int db = 0; db < 2; ++db)
#pragma unroll
    for (int a4 = 0; a4 < 4; ++a4) {
      const int d = db * 32 + 8 * a4 + 4 * h;
      const uint2 uv = *(const uint2*)(zr + UD + g * 64 + d);
      uint2* gp = (uint2*)(zr + GD + g * 64 + d);
      const uint2 gv = *gp;
      uint2 o;
      o.x = pk2(geluf_(bflo(uv.x)) * (acc[db][4 * a4] + bsv) * siluf_(bflo(gv.x)),
                geluf_(bfhi(uv.x)) * (acc[db][4 * a4 + 1] + bsv) * siluf_(bfhi(gv.x)));
      o.y = pk2(geluf_(bflo(uv.y)) * (acc[db][4 * a4 + 2] + bsv) * siluf_(bflo(gv.y)),
                geluf_(bfhi(uv.y)) * (acc[db][4 * a4 + 3] + bsv) * siluf_(bfhi(gv.y)));
      if (dry) gp = (uint2*)(p.blkscr + (size_t)blockIdx.x * 8 * 256 + tid + ((db * 4 + a4) >> 1) * 256) + (a4 & 1);
      *gp = o;
    }
}

#define LDK 72
#define OFF_CK 36864
#define OFF_IMP 37376
#define OFF_SEL (OFF_IMP + 64 * 65 * 4)
#define OFF_WUNI (OFF_SEL + 512)
#define OFF_TL (OFF_WUNI + 64)
enum { M_FOX = 0, M_CMP = 1, M_CMP2 = 2, M_SLC = 3, M_WIN = 4 };

template <int MODE>
DI void attn_run(char* lds, const u16* __restrict__ Kg, const u16* __restrict__ Vg, int kstride,
                 const float* __restrict__ cgl, int nt, int first_tile, const bf16x8 (&qf)[2][4], f32x16 (&O)[2][2],
                 float (&m)[2], float (&l)[2], const int (&qpos)[2], const float (&cq)[2], const u64 (&selb)[2],
                 const float (&linv)[2], int wq0) {
  const int tid = TID(), lane = tid & 63, w = tid >> 6, r = lane & 31, h = lane >> 5;
  u16* Ks = (u16*)lds;
  u16* Vs = Ks + 2 * 64 * LDK;
  float* cks = (float*)(lds + OFF_CK);
  float* imp = (float*)(lds + OFF_IMP);
  const int* tlist = (const int*)(lds + OFF_TL);
  uint4 rk0, rk1, rv0 = make_uint4(0, 0, 0, 0), rv1 = make_uint4(0, 0, 0, 0);
  float rc = 0.f;
  const int lrow = tid >> 3, lcc = tid & 7;
  const int q4 = (lane & 15) >> 2, p4 = lane & 3, blk = (lane >> 4) & 1;

#define KEY0_OF(i_) ((MODE == M_SLC) ? tlist[(i_)] * 64 : ((MODE == M_FOX) ? (nt - 1 - (i_)) * 64 : (first_tile + (i_)) * 64))
#define ALOAD(i_)                                                                               \
  {                                                                                             \
    const int k0_ = KEY0_OF(i_);                                                                \
    rk0 = *(const uint4*)(Kg + (size_t)(k0_ + lrow) * kstride + lcc * 8);                       \
    rk1 = *(const uint4*)(Kg + (size_t)(k0_ + lrow + 32) * kstride + lcc * 8);                  \
    if (MODE != M_CMP2) {                                                                       \
      rv0 = *(const uint4*)(Vg + (size_t)(k0_ + lrow) * kstride + lcc * 8);                     \
      rv1 = *(const uint4*)(Vg + (size_t)(k0_ + lrow + 32) * kstride + lcc * 8);                \
    }                                                                                           \
    if (MODE == M_FOX && tid < 64) rc = cgl[k0_ + tid];                                         \
  }
#define ASTORE(b_)                                                                              \
  {                                                                                             \
    *(uint4*)(Ks + (b_) * 64 * LDK + lrow * LDK + lcc * 8) = rk0;                               \
    *(uint4*)(Ks + (b_) * 64 * LDK + (lrow + 32) * LDK + lcc * 8) = rk1;                        \
    if (MODE != M_CMP2) {                                                                       \
      *(uint4*)(Vs + (b_) * 64 * LDK + lrow * LDK + lcc * 8) = rv0;                             \
      *(uint4*)(Vs + (b_) * 64 * LDK + (lrow + 32) * LDK + lcc * 8) = rv1;                      \
    }                                                                                           \
    if (MODE == M_FOX && tid < 64) cks[(b_) * 64 + tid] = rc;                                   \
  }

  ALOAD(0);
  ASTORE(0);
  __syncthreads();
  for (int it = 0; it < nt; ++it) {
    if (it + 1 < nt) ALOAD(it + 1);
    const int key0 = KEY0_OF(it);
    const u16* Kt = Ks + (it & 1) * 64 * LDK;
    const u16* Vt = Vs + (it & 1) * 64 * LDK;
    const float* ckt = cks + (it & 1) * 64;
#pragma unroll 1
    for (int kb = 0; kb < 2; ++kb) {
      const int kbase = key0 + kb * 32;
      bool need = true;
      if (MODE == M_FOX || MODE == M_SLC) need = (kbase <= wq0 + 63);
      if (MODE == M_WIN) need = (kbase <= wq0 + 63) && (kbase + 31 > wq0 - 512);
      if (MODE == M_CMP) need = (16 * kbase + 31 <= wq0 + 63);
      float mainv[2][4], spill[2][4];
      if (need) {
        bool domask = true;
        if (MODE == M_FOX || MODE == M_SLC) domask = (kbase + 31 > wq0);
        if (MODE == M_WIN) domask = (kbase + 31 > wq0) || (kbase <= wq0 + 63 - 512);
        bf16x8 pk[2][2];
#pragma unroll
        for (int nb = 0; nb < 2; ++nb) {
          f32x16 Sn;
          if (MODE == M_FOX) {
#pragma unroll
            for (int a4 = 0; a4 < 4; ++a4) {
              const float4 c4 = *(const float4*)(ckt + kb * 32 + 8 * a4 + 4 * h);
              Sn[4 * a4] = cq[nb] - c4.x; Sn[4 * a4 + 1] = cq[nb] - c4.y; Sn[4 * a4 + 2] = cq[nb] - c4.z; Sn[4 * a4 + 3] = cq[nb] - c4.w;
            }
          } else {
#pragma unroll
            for (int i = 0; i < 16; ++i) Sn[i] = 0.f;
          }
#pragma unroll
          for (int ks = 0; ks < 4; ++ks) {
            const bf16x8 a = *(const bf16x8*)(Kt + (kb * 32 + r) * LDK + ks * 16 + 8 * h);
            Sn = MFMA(a, qf[nb][ks], Sn);
          }
          float sv[16];
          const int t = qpos[nb];
          bool sb = true;
          if (MODE == M_SLC) sb = (((selb[nb] >> (key0 >> 6)) & 1ull) != 0ull);
          if (domask) {
#pragma unroll
            for (int i = 0; i < 16; ++i) {
              const int kk = kbase + (i & 3) + 8 * (i >> 2) + 4 * h;
              bool valid;
              if (MODE == M_FOX) valid = (kk <= t);
              else if (MODE == M_CMP || MODE == M_CMP2) valid = (16 * kk + 31 <= t) && (kk < 255);
              else if (MODE == M_SLC) valid = sb && (kk <= t);
              else valid = (kk <= t) && (kk > t - 512);
              sv[i] = valid ? Sn[i] : -INFINITY;
            }
          } else {
#pragma unroll
            for (int i = 0; i < 16; ++i) sv[i] = (MODE == M_SLC) ? (sb ? Sn[i] : -INFINITY) : Sn[i];
          }
          if (MODE == M_CMP2) {
#pragma unroll
            for (int a4 = 0; a4 < 4; ++a4) {
              float pe[4];
#pragma unroll
              for (int e = 0; e < 4; ++e) pe[e] = __builtin_amdgcn_exp2f(sv[4 * a4 + e] - m[nb]) * linv[nb];
              mainv[nb][a4] = pe[0] + pe[1] + pe[2] + 0.5f * pe[3];
              spill[nb][a4] = 0.5f * pe[3];
            }
          } else {
            float mx = sv[0];
#pragma unroll
            for (int i = 1; i < 16; ++i) mx = fmaxf(mx, sv[i]);
            mx = fmaxf(mx, shx(mx, lane, 32));
            if (__any(mx > m[nb] + 8.f)) {
              const float mnew = (mx > m[nb] + 8.f) ? mx : m[nb];
              const float alpha = __builtin_amdgcn_exp2f(m[nb] - mnew);
              m[nb] = mnew;
              l[nb] *= alpha;
#pragma unroll
              for (int i = 0; i < 16; ++i) { O[0][nb][i] *= alpha; O[1][nb][i] *= alpha; }
            }
            const float mc = m[nb];
            float ps = 0.f;
#pragma unroll
            for (int i = 0; i < 16; ++i) {
              sv[i] = __builtin_amdgcn_exp2f(sv[i] - mc);
              ps += sv[i];
            }
            l[nb] += ps;
#pragma unroll
            for (int s2 = 0; s2 < 2; ++s2) {
              const unsigned u0 = pk2(sv[8 * s2], sv[8 * s2 + 1]), u1 = pk2(sv[8 * s2 + 2], sv[8 * s2 + 3]);
              const unsigned u2 = pk2(sv[8 * s2 + 4], sv[8 * s2 + 5]), u3 = pk2(sv[8 * s2 + 6], sv[8 * s2 + 7]);
              const uint4 uu = make_uint4(u0, u1, u2, u3);
              pk[nb][s2] = __builtin_bit_cast(bf16x8, uu);
            }
          }
        }
        if (MODE != M_CMP2) {
#pragma unroll
          for (int s2 = 0; s2 < 2; ++s2) {
#pragma unroll
            for (int db = 0; db < 2; ++db) {
              const u16* vp = Vt + (kb * 32 + 16 * s2 + 4 * h + q4) * LDK + db * 32 + 16 * blk + 4 * p4;
              const s16x4 lo = __builtin_amdgcn_ds_read_tr16_b64_v4i16((__attribute__((address_space(3))) s16x4*)(vp));
              const s16x4 hi = __builtin_amdgcn_ds_read_tr16_b64_v4i16((__attribute__((address_space(3))) s16x4*)(vp + 8 * LDK));
              const bf16x8 a = __builtin_shufflevector(lo, hi, 0, 1, 2, 3, 4, 5, 6, 7);
              O[db][0] = MFMA(a, pk[0][s2], O[db][0]);
              O[db][1] = MFMA(a, pk[1][s2], O[db][1]);
            }
          }
        }
      }
      if (MODE == M_CMP2) {
        const int jb = (kbase >> 2) + h;
        for (int rr = 0; rr < 4; ++rr) {
          if (w == rr) {
#pragma unroll
            for (int nb = 0; nb < 2; ++nb)
#pragma unroll
              for (int a4 = 0; a4 < 4; ++a4) imp[(nb * 32 + r) * 65 + jb + 2 * a4] += mainv[nb][a4];
#pragma unroll
            for (int nb = 0; nb < 2; ++nb)
#pragma unroll
              for (int a4 = 0; a4 < 4; ++a4) imp[(nb * 32 + r) * 65 + jb + 2 * a4 + 1] += spill[nb][a4];
          }
          __syncthreads();
        }
      }
    }
    if (it + 1 < nt) ASTORE((it + 1) & 1);
    __syncthreads();
  }
#undef KEY0_OF
#undef ALOAD
#undef ASTORE
}

DI void attn_init(f32x16 (&O)[2][2], float (&m)[2], float (&l)[2]) {
#pragma unroll
  for (int a = 0; a < 2; ++a)
#pragma unroll
    for (int b = 0; b < 2; ++b)
#pragma unroll
      for (int i = 0; i < 16; ++i) O[a][b][i] = 0.f;
  m[0] = m[1] = NEGBIG;
  l[0] = l[1] = 0.f;
}

DI void fox_item(const Params& p, int l_, int item, char* lds, int dry) {
  const int qb = 15 - (item >> 5), bh = item & 31, b = bh >> 3, hd = bh & 7;
  const int tid = TID(), lane = tid & 63, w = tid >> 6, r = lane & 31, h = lane >> 5;
  const int wq0 = qb * 256 + w * 64;
  const int qpos[2] = {wq0 + r, wq0 + 32 + r};
  u16* zb = p.z + (size_t)b * S_ * ZS;
  bf16x8 qf[2][4];
#pragma unroll
  for (int nb = 0; nb < 2; ++nb)
#pragma unroll
    for (int ks = 0; ks < 4; ++ks)
      qf[nb][ks] = *(const bf16x8*)(zb + (size_t)qpos[nb] * ZS + QA + hd * 64 + ks * 16 + 8 * h);
  const float* cb = p.cbuf + (size_t)(b * 8 + hd) * S_;
  const float cq[2] = {cb[qpos[0]], cb[qpos[1]]};
  f32x16 O[2][2];
  float m[2], l[2];
  attn_init(O, m, l);
  const u64 selb[2] = {0ull, 0ull};
  const float linv[2] = {0.f, 0.f};
  attn_run<M_FOX>(lds, zb + KA + hd * 64, zb + VA + hd * 64, ZS, cb, 4 * (qb + 1), 0, qf, O, m, l, qpos, cq, selb, linv, wq0);
#pragma unroll
  for (int nb = 0; nb < 2; ++nb) {
    const float lt = l[nb] + shx(l[nb], lane, 32);
    const float inv = (lt > 0.f) ? 1.f / lt : 0.f;
    u16* zr = zb + (size_t)qpos[nb] * ZS + GA + hd * 64;
#pragma unroll
    for (int db = 0; db < 2; ++db)
#pragma unroll
      for (int a4 = 0; a4 < 4; ++a4) {
        uint2* gp = (uint2*)(zr + db * 32 + 8 * a4 + 4 * h);
        const uint2 gv = *gp;
        uint2 o;
        o.x = pk2(O[db][nb][4 * a4] * inv * siluf_(bflo(gv.x)), O[db][nb][4 * a4 + 1] * inv * siluf_(bfhi(gv.x)));
        o.y = pk2(O[db][nb][4 * a4 + 2] * inv * siluf_(bflo(gv.y)), O[db][nb][4 * a4 + 3] * inv * siluf_(bfhi(gv.y)));
        if (dry) gp = (uint2*)(p.blkscr + (size_t)blockIdx.x * 8 * 256 + tid + ((nb * 8 + db * 4 + a4) >> 1) * 256) + (a4 & 1);
        *gp = o;
      }
  }
}

DI void nsa_item(const Params& p, int l_, int item, char* lds, int dry) {
  const int qb = 63 - (item >> 3), bg = item & 7, b = bg >> 1, g = bg & 1;
  const int tid = TID(), lane = tid & 63, w = tid >> 6, r = lane & 31, h = lane >> 5;
  const int head = g * 4 + w;
  float* imp = (float*)(lds + OFF_IMP);
  u64* selm = (u64*)(lds + OFF_SEL);
  u64* wuni = (u64*)(lds + OFF_WUNI);
  int* tlist = (int*)(lds + OFF_TL);
  for (int i = tid; i < 64 * 65; i += 256) imp[i] = 0.f;
  const int wq0 = qb * 64;
  const int qpos[2] = {wq0 + r, wq0 + 32 + r};
  u16* zb = p.z + (size_t)b * S_ * ZS;
  bf16x8 qf[2][4];
#pragma unroll
  for (int nb = 0; nb < 2; ++nb)
#pragma unroll
    for (int ks = 0; ks < 4; ++ks)
      qf[nb][ks] = *(const bf16x8*)(zb + (size_t)qpos[nb] * ZS + QC + head * 64 + ks * 16 + 8 * h);
#define scr (p.blkscr + (size_t)blockIdx.x * 8 * 256 + TID())
#define NSA_GATE(c_, nb_) sigmoidf_(bf2f(zb[(size_t)qpos[nb_] * ZS + GATEC + (c_) * 8 + head]))
  const float cq[2] = {0.f, 0.f};
  u64 selb[2] = {0ull, 0ull};
  float linv[2] = {0.f, 0.f};
  f32x16 O[2][2];
  float m[2], l[2];

  attn_init(O, m, l);
  const u16* kcp = p.kc + (size_t)(b * 2 + g) * 256 * 64;
  const u16* vcp = p.vc + (size_t)(b * 2 + g) * 256 * 64;
  attn_run<M_CMP>(lds, kcp, vcp, 64, nullptr, 4, 0, qf, O, m, l, qpos, cq, selb, linv, wq0);
#pragma unroll
  for (int nb = 0; nb < 2; ++nb) {
    const float lt = l[nb] + shx(l[nb], lane, 32);
    linv[nb] = (lt > 0.f) ? 1.f / lt : 0.f;
    const float sc = linv[nb] * NSA_GATE(0, nb);
#pragma unroll
    for (int db = 0; db < 2; ++db)
#pragma unroll
      for (int i = 0; i < 2; ++i) {
        uint4 o;
        o.x = pk2(O[db][nb][8 * i] * sc, O[db][nb][8 * i + 1] * sc);
        o.y = pk2(O[db][nb][8 * i + 2] * sc, O[db][nb][8 * i + 3] * sc);
        o.z = pk2(O[db][nb][8 * i + 4] * sc, O[db][nb][8 * i + 5] * sc);
        o.w = pk2(O[db][nb][8 * i + 6] * sc, O[db][nb][8 * i + 7] * sc);
        scr[((nb * 2 + db) * 2 + i) * 256] = o;
      }
  }
  attn_run<M_CMP2>(lds, kcp, vcp, 64, nullptr, 4, 0, qf, O, m, l, qpos, cq, selb, linv, wq0);
  {
    u64 uni = 0ull;
    const int j = lane;
    const bool valid = (j <= qb);
    const bool forced = (j == 0) || (valid && j > qb - 2);
    for (int qq = 0; qq < 16; ++qq) {
      const int q = 16 * w + qq;
      const float sc = forced ? 1e6f : (valid ? imp[q * 65 + j] : -1.f);
      int rank = 0;
#pragma unroll
      for (int i = 0; i < 64; ++i) {
        const float si = __int_as_float(__builtin_amdgcn_readlane(__float_as_int(sc), i));
        rank += ((si > sc) || (si == sc && i < j)) ? 1 : 0;
      }
      const bool sel = (rank < 16) && (sc >= 0.f);
      const u64 mk = __ballot(sel);
      if (lane == 0) selm[q] = mk;
      uni |= mk;
    }
    if (lane == 0) wuni[w] = uni;
  }
  __syncthreads();
  const u64 U = wuni[0] | wuni[1] | wuni[2] | wuni[3];
  if (w == 0 && ((U >> lane) & 1ull)) tlist[__popcll(U & ((1ull << lane) - 1ull))] = lane;
  const int ntl = __popcll(U);
  selb[0] = selm[r];
  selb[1] = selm[32 + r];
  __syncthreads();
  attn_init(O, m, l);
  attn_run<M_SLC>(lds, zb + KSC + g * 64, zb + VSC + g * 64, ZS, nullptr, ntl, 0, qf, O, m, l, qpos, cq, selb, linv, wq0);
#pragma unroll
  for (int nb = 0; nb < 2; ++nb) {
    const float lt = l[nb] + shx(l[nb], lane, 32);
    const float sc = ((lt > 0.f) ? 1.f / lt : 0.f) * NSA_GATE(1, nb);
#pragma unroll
    for (int db = 0; db < 2; ++db)
#pragma unroll
      for (int i = 0; i < 2; ++i) {
        uint4 o = scr[((nb * 2 + db) * 2 + i) * 256];
        o.x = pk2(bflo(o.x) + O[db][nb][8 * i] * sc, bfhi(o.x) + O[db][nb][8 * i + 1] * sc);
        o.y = pk2(bflo(o.y) + O[db][nb][8 * i + 2] * sc, bfhi(o.y) + O[db][nb][8 * i + 3] * sc);
        o.z = pk2(bflo(o.z) + O[db][nb][8 * i + 4] * sc, bfhi(o.z) + O[db][nb][8 * i + 5] * sc);
        o.w = pk2(bflo(o.w) + O[db][nb][8 * i + 6] * sc, bfhi(o.w) + O[db][nb][8 * i + 7] * sc);
        scr[((nb * 2 + db) * 2 + i) * 256] = o;
      }
  }
  attn_init(O, m, l);
  const int first = (qb >= 8) ? qb - 8 : 0;
  attn_run<M_WIN>(lds, zb + KWC + g * 64, zb + VWC + g * 64, ZS, nullptr, qb - first + 1, first, qf, O, m, l, qpos, cq, selb, linv, wq0);
#pragma unroll
  for (int nb = 0; nb < 2; ++nb) {
    const float lt = l[nb] + shx(l[nb], lane, 32);
    const float sc = ((lt > 0.f) ? 1.f / lt : 0.f) * NSA_GATE(2, nb);
    u16* zr = zb + (size_t)qpos[nb] * ZS + GC + head * 64;
#pragma unroll
    for (int db = 0; db < 2; ++db)
#pragma unroll
      for (int a4 = 0; a4 < 4; ++a4) {
        uint2* gp = (uint2*)(zr + db * 32 + 8 * a4 + 4 * h);
        const uint2 gv = *gp;
        const uint2 pv = *((const uint2*)&scr[((nb * 2 + db) * 2 + (a4 >> 1)) * 256] + (a4 & 1));
        const unsigned o0 = pv.x, o1 = pv.y;
        uint2 o;
        o.x = pk2((bflo(o0) + O[db][nb][4 * a4] * sc) * siluf_(bflo(gv.x)),
                  (bfhi(o0) + O[db][nb][4 * a4 + 1] * sc) * siluf_(bfhi(gv.x)));
        o.y = pk2((bflo(o1) + O[db][nb][4 * a4 + 2] * sc) * siluf_(bflo(gv.y)),
                  (bfhi(o1) + O[db][nb][4 * a4 + 3] * sc) * siluf_(bfhi(gv.y)));
        if (dry) gp = (uint2*)&scr[((nb * 2 + db) * 2 + (a4 >> 1)) * 256] + (a4 & 1);
        *gp = o;
      }
  }
}

#undef scr
#define XB_TMO      128
#define XB_XCNT(j)  (256  + 64 * (j))
#define XB_XSUB(j)  (1280 + 64 * (j))
#define XB_XGEN(j)  (2304 + 64 * (j))
#define XB_TOP      3328
#define XB_TOPGEN   3392
#define XCD_BAR_WORDS 3456
#define XB_SPIN_CAP (1u << 18)
#define LAS __attribute__((address_space(3)))

__device__ __forceinline__ unsigned xb_ld(unsigned* p)              { return __hip_atomic_load(p, __ATOMIC_RELAXED, __HIP_MEMORY_SCOPE_AGENT); }
__device__ __forceinline__ unsigned xb_add(unsigned* p, unsigned v) { return __hip_atomic_fetch_add(p, v, __ATOMIC_RELAXED, __HIP_MEMORY_SCOPE_AGENT); }
__device__ __forceinline__ unsigned xb_xcc_id() { return (unsigned)__builtin_amdgcn_s_getreg((3 << 11) | 20) & 0xFu; }
#define XB_SPIN(cond, bar) do { unsigned _sp = 0; while (cond) { __builtin_amdgcn_s_sleep(1); \
    if ((++_sp & 255u) == 0u) { if (xb_ld(&(bar)[XB_TMO])) break; if (_sp > XB_SPIN_CAP) { atomicAdd(&(bar)[XB_TMO], 1u); break; } } } } while (0)

struct XcdBarrier {
    unsigned* bar; unsigned x;
    volatile LAS unsigned* st;
};

__device__ __forceinline__ XcdBarrier xcd_barrier_post(unsigned* bar, volatile LAS unsigned* st) {
    XcdBarrier b; b.bar = bar; b.x = xb_xcc_id(); b.st = st;
    if (threadIdx.x == 0) (void)xb_add(&bar[XB_XCNT(b.x)], 1u);
    return b;
}
__device__ __forceinline__ void xcd_barrier_complete(unsigned* bar, unsigned x, unsigned& nloc, unsigned& nx) {
    const unsigned G = gridDim.x * gridDim.y * gridDim.z;
    unsigned sum, cnt, mine, sp = 0u;
    for (;;) {
        sum = 0u; cnt = 0u; mine = 0u;
#pragma unroll
        for (unsigned j = 0; j < 16; ++j) { const unsigned c = xb_ld(&bar[XB_XCNT(j)]); sum += c; cnt += (c > 0u) ? 1u : 0u; mine = (j == x) ? c : mine; }
        if (sum == G) break;
        __builtin_amdgcn_s_sleep(1);
        if ((++sp & 255u) == 0u) { if (xb_ld(&bar[XB_TMO])) break; if (sp > XB_SPIN_CAP) { atomicAdd(&bar[XB_TMO], 1u); break; } }
    }
    nloc = mine > 0u ? mine : 1u; nx = cnt > 0u ? cnt : 1u;
}

__device__ __forceinline__ void xcd_barrier(const XcdBarrier& b) {
    asm volatile("s_waitcnt vmcnt(0)" ::: "memory");
    __syncthreads();
    if (threadIdx.x == 0) {
        unsigned* bar = b.bar;
        __builtin_amdgcn_s_waitcnt(0);
        unsigned nloc = b.st[0], nx = b.st[1];
        if (nloc == 0u) { xcd_barrier_complete(bar, b.x, nloc, nx); b.st[0] = nloc; b.st[1] = nx; }
        const unsigned old = xb_add(&bar[XB_XSUB(b.x)], 1u);
        const unsigned gen = old / nloc;
        if (old + 1u == (gen + 1u) * nloc) {
            __builtin_amdgcn_fence(__ATOMIC_RELEASE, "agent");
            asm volatile("s_waitcnt vmcnt(0)" ::: "memory");
            const unsigned og = xb_add(&bar[XB_TOP], 1u);
            const unsigned tg = og / nx;
            if (og + 1u == (tg + 1u) * nx) xb_add(&bar[XB_TOPGEN], 1u);
            else XB_SPIN(xb_ld(&bar[XB_TOPGEN]) == tg, bar);
            __builtin_amdgcn_fence(__ATOMIC_ACQUIRE, "agent");
            xb_add(&bar[XB_XGEN(b.x)], 1u);
            asm volatile("s_waitcnt vmcnt(0)" ::: "memory");
        } else {
            XB_SPIN(xb_ld(&bar[XB_XGEN(b.x)]) == gen, bar);
            __builtin_amdgcn_fence(__ATOMIC_ACQUIRE, "agent");
            asm volatile("s_waitcnt vmcnt(0)" ::: "memory");
        }
    }
    __syncthreads();
}


__global__ void __launch_bounds__(256, 2) hybrid_fwd(Params p) {
  cg::grid_group grid = cg::this_grid();
  __shared__ __attribute__((aligned(16))) char lds[LDS_BYTES];
  __shared__ int slot;
  __shared__ uint4 xb_words;
  if (threadIdx.x == 0) xb_words = make_uint4(0u, 0u, 0u, 0u);
  __syncthreads();
  const XcdBarrier xb = xcd_barrier_post(p.bar, (volatile LAS unsigned*)&xb_words);
  for (int l = 0; l < 2; ++l) {
    const float* xin = (l == 0) ? p.x : p.out;
    for (int rep = 0; rep < REP_P0; ++rep) phase0(p, l, xin, lds);
    if (l == 0) grid.sync(); else xcd_barrier(xb);
    for (int rep = 0; rep < REP_P1; ++rep) phase1(p, lds);
    xcd_barrier(xb);
    {
      for (int rep = 0; rep < REP_P2; ++rep) {
        int* ctr = p.ctr + l * 2 + rep * 8;
        const int dry = (rep + 1 < REP_P2) ? 1 : 0;
        for (;;) {
          const int it = pop_item(ctr, &slot);
          if (it >= 2624) break;
          if (it < 32) { if (!dry || (P2_MASK & 1)) compress_item(p, l, it, lds); }
          else if (it < 2080) { if (!dry || (P2_MASK & 2)) lru_item(p, l, it - 32, 1, lds); }
          else if (it < 2112) { if (!dry || (P2_MASK & 4)) cumsum_item(p, l, it - 2080, lds); }
          else if (it < 2368) { if (!dry || (P2_MASK & 8)) headnorm_item(p, l, it - 2112, dry); }
          else { if (!dry || (P2_MASK & 16)) sgprep_item(p, l, it - 2368, dry); }
        }
      }
    }
    xcd_barrier(xb);
    {
      for (int rep = 0; rep < REP_P3; ++rep) {
        const int dry = (rep + 1 < REP_P3) ? 1 : 0;
        int* ctr = p.ctr + l * 2 + 1 + rep * 4;
        for (;;) {
          const int it = pop_item(ctr, &slot);
          if (it >= 1024) break;
          if (it < 512) { if (!dry || (P3_MASK & 1)) nsa_item(p, l, it, lds, dry); }
          else { if (!dry || (P3_MASK & 2)) fox_item(p, l, it - 512, lds, dry); }
        }
        int* ctr2 = p.ctr + 32 + l * 2 + rep * 4;
        for (;;) {
          const int it = pop_item(ctr2, &slot);
          if (it >= 3072) break;
          if (it < 2048) { if (!dry || (P3_MASK & 4)) lru_item(p, l, it, 2, lds, dry); }
          else { if (!dry || (P3_MASK & 8)) sg_item(p, l, it - 2048, lds, dry); }
        }
      }
    }
    xcd_barrier(xb);
    for (int rep = 0; rep < REP_P4; ++rep) phase4(p, lds);
    xcd_barrier(xb);
    for (int rep = 0; rep < ((l == 0) ? REP_P5 : 1); ++rep) phase5(p, xin, p.out, lds);
    if (l == 0) xcd_barrier(xb);
  }
}

extern "C" void kernel_launch(void* const* d_in, const int* in_sizes, int n_in, void* d_out, int out_size, void* d_ws,
                              size_t ws_size, hipStream_t stream) {
  static int grid_blocks = 0;
  if (!grid_blocks) {
    int dev = 0, cus = 0, per_cu = 0;
    hipGetDevice(&dev);
    hipDeviceGetAttribute(&cus, hipDeviceAttributeMultiprocessorCount, dev);
    hipOccupancyMaxActiveBlocksPerMultiprocessor(&per_cu, hybrid_fwd, 256, 0);
    if (per_cu > 2) per_cu = 2;
    if (per_cu < 1) per_cu = 1;
    grid_blocks = cus * per_cu;
  }
  Params p{};
  const float** f = (const float**)&p;
  for (int i = 0; i < 25; ++i) f[i] = (const float*)d_in[i];
  p.out = (float*)d_out;
  char* ws = (char*)d_ws;
  size_t off = 0;
  auto take = [&](size_t bytes) { char* r = ws + off; off += (bytes + 255) & ~(size_t)255; return r; };
  p.ctr = (int*)take(256);
  p.bar = (unsigned*)take((size_t)XCD_BAR_WORDS * 4);
  p.z = (u16*)take((size_t)T_ * ZS * 2);
  p.xn = (u16*)take((size_t)T_ * 1024 * 2);
  p.WinT = (u16*)take((size_t)6528 * 1024 * 2);
  p.WgT = (u16*)take((size_t)4096 * 1024 * 2);
  p.WbT = (u16*)take((size_t)4 * 1024 * 512 * 2);
  p.WoT = (u16*)take((size_t)1024 * 1024 * 2);
  p.cbuf = (float*)take((size_t)4 * 8 * S_ * 4);
  p.lrusum = (float*)take((size_t)4 * 64 * 512 * 2 * 4);
  p.kc = (u16*)take((size_t)4 * 2 * 256 * 64 * 2);
  p.vc = (u16*)take((size_t)4 * 2 * 256 * 64 * 2);
  p.W1T = (u16*)take((size_t)2 * 128 * 2048 * 2);
  p.pospart = (float*)take((size_t)2 * 32 * 128 * 4);
  p.blkscr = (uint4*)take((size_t)grid_blocks * 8 * 256 * 16);
  hipMemsetAsync(p.ctr, 0, 256 + (((size_t)XCD_BAR_WORDS * 4 + 255) & ~(size_t)255), stream);
  void* args[] = {&p};
  hipError_t e = hipLaunchCooperativeKernel((void*)hybrid_fwd, dim3(grid_blocks), dim3(256), args, 0, stream);
  if (e != hipSuccess) fprintf(stderr, "cooperative launch failed: %s (grid %d)\n", hipGetErrorString(e), grid_blocks);
}
```

```cpp
#include <hip/hip_runtime.h>
#include <hip/hip_cooperative_groups.h>
#include <cstdio>
namespace cg = cooperative_groups;

typedef unsigned short u16;
typedef unsigned long long u64;
typedef short bf16x8 __attribute__((ext_vector_type(8)));
typedef short s16x4 __attribute__((ext_vector_type(4)));
typedef float f32x16 __attribute__((ext_vector_type(16)));
typedef _Float16 bf2_t __attribute__((ext_vector_type(2)));
typedef _Float16 h16x8 __attribute__((ext_vector_type(8)));
typedef float f2_t __attribute__((ext_vector_type(2)));

#define DI __device__ __forceinline__
#define MFMA(a, b, c) __builtin_amdgcn_mfma_f32_32x32x16_f16(__builtin_bit_cast(h16x8, (a)), __builtin_bit_cast(h16x8, (b)), (c), 0, 0, 0)

#define S_ 4096
#define T_ 16384
#define ZS 6528
#define QA 0
#define KA 512
#define VA 1024
#define GA 1536
#define XB 2048
#define GB 2560
#define QC 3072
#define KCC 3584
#define VCC 3712
#define KSC 3840
#define VSC 3968
#define KWC 4096
#define VWC 4224
#define GC 4352
#define UD 4864
#define VD 5376
#define GD 5888
#define FA 6400
#define GATEC 6408
#define LOG2E 1.4426950408889634f
#define QSCALE (0.125f * LOG2E)
#define NEGBIG (-1e30f)
#define LDS_BYTES 73728
#ifndef REP_P0
#define REP_P0 1
#endif
#ifndef REP_P1
#define REP_P1 1
#endif
#ifndef REP_P2
#define REP_P2 1
#endif
#ifndef P2_MASK
#define P2_MASK 31
#endif
#ifndef REP_P5
#define REP_P5 1
#endif
#ifndef REP_P3
#define REP_P3 1
#endif
#ifndef P3_MASK
#define P3_MASK 15
#endif
#ifndef REP_P4
#define REP_P4 1
#endif

struct Params {
  const float *x, *norm_g, *w_in, *b_forget, *qn_a, *kn_a, *conv_w, *conv_b, *w_rg_a, *b_rg_a, *w_rg_x, *b_rg_x,
      *lru_lambda, *qn_c, *kn_c, *cmp_pos, *cmp_k_w1, *cmp_k_w2, *cmp_v_w1, *cmp_v_w2, *ln_v_g, *w_spatial,
      *b_spatial, *w_branch, *w_out;
  float* out;
  int* ctr;
  u16 *z, *xn, *WinT, *WgT, *WbT, *WoT;
  float *cbuf, *lrusum;
  u16 *kc, *vc;
  uint4* blkscr;
  u16* W1T;
  float* pospart;
  unsigned* bar;
};

DI unsigned pk2(float a, float b) { f2_t v = {a, b}; bf2_t r = __builtin_convertvector(v, bf2_t); return __builtin_bit_cast(unsigned, r); }
DI float bflo(unsigned u) { return (float)__builtin_bit_cast(bf2_t, u)[0]; }
DI float bfhi(unsigned u) { return (float)__builtin_bit_cast(bf2_t, u)[1]; }
DI float bf2f(u16 v) { return (float)__builtin_bit_cast(_Float16, v); }
DI u16 f2bf(float x) { return (u16)(pk2(x, 0.f) & 0xffffu); }
DI float sigmoidf_(float x) { return 1.f / (1.f + __expf(-x)); }
DI float siluf_(float x) { return x / (1.f + __expf(-x)); }
DI float geluf_(float x) { return 0.5f * x * (1.f + erff(x * 0.70710678118654752f)); }
DI float shx(float v, int lane, int mask) {
  return __int_as_float(__builtin_amdgcn_ds_bpermute((lane ^ mask) << 2, __float_as_int(v)));
}
DI float wave_sum(float v, int lane) {
#pragma unroll
  for (int o = 32; o > 0; o >>= 1) v += shx(v, lane, o);
  return v;
}
DI int TID() { int t = threadIdx.x; asm volatile("" : "+v"(t)); return t; }
DI int pop_item(int* ctr, int* slot) {
  __syncthreads();
  if (threadIdx.x == 0) *slot = atomicAdd(ctr, 1);
  __syncthreads();
  return *slot;
}

#define LDT 72
#define GEMM_GL1(P, i_, kt_)                                                                           \
  P##a##i_ = *(const uint4*)(Ag + (size_t)(row0 + 32 * i_) * lda + (size_t)(kt_) * akstep + cc * 8);   \
  P##b##i_ = *(const uint4*)(Bg + (size_t)(row0 + 32 * i_) * ldb + (kt_) * 64 + cc * 8);
#define GEMM_GLOAD(P, kt_) { GEMM_GL1(P, 0, kt_) GEMM_GL1(P, 1, kt_) GEMM_GL1(P, 2, kt_) GEMM_GL1(P, 3, kt_) }
#define GEMM_LS1(P, i_, buf_)                                                                  \
  *(uint4*)(As + (buf_) * 128 * LDT + (row0 + 32 * i_) * LDT + cc * 8) = P##a##i_;              \
  *(uint4*)(Bs + (buf_) * 128 * LDT + (row0 + 32 * i_) * LDT + cc * 8) = P##b##i_;
#define GEMM_LSTORE(P, buf_) { GEMM_LS1(P, 0, buf_) GEMM_LS1(P, 1, buf_) GEMM_LS1(P, 2, buf_) GEMM_LS1(P, 3, buf_) }
#define GEMM_COMPUTE(buf_)                                                                               \
  {                                                                                                      \
    const u16* a_ = As + (buf_) * 128 * LDT + (wm * 64 + r) * LDT + 8 * h;                               \
    const u16* b_ = Bs + (buf_) * 128 * LDT + (wn * 64 + r) * LDT + 8 * h;                               \
    _Pragma("unroll") for (int ks = 0; ks < 4; ++ks) {                                                   \
      const bf16x8 a0 = *(const bf16x8*)(a_ + ks * 16);                                                  \
      const bf16x8 a1 = *(const bf16x8*)(a_ + 32 * LDT + ks * 16);                                       \
      const bf16x8 b0 = *(const bf16x8*)(b_ + ks * 16);                                                  \
      const bf16x8 b1 = *(const bf16x8*)(b_ + 32 * LDT + ks * 16);                                       \
      acc[0][0] = MFMA(b0, a0, acc[0][0]);                                                               \
      acc[0][1] = MFMA(b1, a0, acc[0][1]);                                                               \
      acc[1][0] = MFMA(b0, a1, acc[1][0]);                                                               \
      acc[1][1] = MFMA(b1, a1, acc[1][1]);                                                               \
    }                                                                                                    \
  }
template <bool DEEP>
DI void gemm_mainloop_t(const u16* __restrict__ Ag, int lda, const u16* __restrict__ Bg, int ldb, int K, char* ldsraw,
                        f32x16 (&acc)[2][2], int akstep) {
  const int tid = TID(), lane = tid & 63, w = tid >> 6, wm = w >> 1, wn = w & 1, r = lane & 31, h = lane >> 5;
  u16* As = (u16*)ldsraw;
  u16* Bs = As + 2 * 128 * LDT;
  uint4 xa0, xa1, xa2, xa3, xb0, xb1, xb2, xb3;
  const int nk = K >> 6;
  const int row0 = tid >> 3, cc = tid & 7;
  if (DEEP) {
    uint4 ya0, ya1, ya2, ya3, yb0, yb1, yb2, yb3;
    GEMM_GLOAD(x, 0);
    GEMM_GLOAD(y, 1);
    GEMM_LSTORE(x, 0);
    __syncthreads();
    for (int kt = 0; kt < nk; kt += 2) {
      if (kt + 2 < nk) GEMM_GLOAD(x, kt + 2);
      GEMM_COMPUTE(0);
      GEMM_LSTORE(y, 1);
      __syncthreads();
      if (kt + 3 < nk) GEMM_GLOAD(y, kt + 3);
      GEMM_COMPUTE(1);
      if (kt + 2 < nk) GEMM_LSTORE(x, 0);
      __syncthreads();
    }
  } else {
    GEMM_GLOAD(x, 0);
    GEMM_LSTORE(x, 0);
    __syncthreads();
    for (int kt = 0; kt < nk; kt += 2) {
      GEMM_GLOAD(x, kt + 1);
      GEMM_COMPUTE(0);
      GEMM_LSTORE(x, 1);
      __syncthreads();
      if (kt + 2 < nk) GEMM_GLOAD(x, kt + 2);
      GEMM_COMPUTE(1);
      if (kt + 2 < nk) GEMM_LSTORE(x, 0);
      __syncthreads();
    }
  }
}
DI void gemm_mainloop(const u16* __restrict__ Ag, int lda, const u16* __restrict__ Bg, int ldb, int K, char* ldsraw,
                      f32x16 (&acc)[2][2], int akstep = 64) {
  gemm_mainloop_t<true>(Ag, lda, Bg, ldb, K, ldsraw, acc, akstep);
}
DI void gemm_mainloop_shallow(const u16* __restrict__ Ag, int lda, const u16* __restrict__ Bg, int ldb, int K, char* ldsraw,
                              f32x16 (&acc)[2][2]) {
  gemm_mainloop_t<false>(Ag, lda, Bg, ldb, K, ldsraw, acc, 64);
}

DI void zero_acc(f32x16 (&acc)[2][2]) {
#pragma unroll
  for (int a = 0; a < 2; ++a)
#pragma unroll
    for (int b = 0; b < 2; ++b)
#pragma unroll
      for (int i = 0; i < 16; ++i) acc[a][b][i] = 0.f;
}

DI int win_srccol(int n) {
  if (n < 1536) return n;
  if (n < 4352) return n + 8;
  if (n < 6400) return n + 32;
  if (n < 6408) return 1536 + (n - 6400);
  if (n < 6432) return 4360 + (n - 6408);
  return -1;
}
DI void transpose_tile(const float* __restrict__ src, int sld, int k0, int n0, int kind, u16* __restrict__ dst, int dld,
                       char* ldsraw) {
  float* t = (float*)ldsraw;
  const int tid = TID();
  {
    const int nn = tid & 63, kq = tid >> 6;
    const int n = n0 + nn;
    const int sc = (kind == 0) ? win_srccol(n) : ((kind == 1) ? 6432 + n : n);
#pragma unroll
    for (int i = 0; i < 16; ++i) {
      const int kk = kq * 16 + i;
      t[kk * 65 + nn] = (sc >= 0) ? src[(size_t)(k0 + kk) * sld + sc] : 0.f;
    }
  }
  __syncthreads();
  {
    const int nn = tid >> 2, ks = (tid & 3) * 16;
    unsigned o[8];
#pragma unroll
    for (int i = 0; i < 8; ++i) o[i] = pk2(t[(ks + 2 * i) * 65 + nn], t[(ks + 2 * i + 1) * 65 + nn]);
    uint4* d = (uint4*)(dst + (size_t)(n0 + nn) * dld + k0 + ks);
    d[0] = make_uint4(o[0], o[1], o[2], o[3]);
    d[1] = make_uint4(o[4], o[5], o[6], o[7]);
  }
  __syncthreads();
}

DI void phase0(const Params& p, int l, const float* __restrict__ xin, char* lds) {
  const int NI = 1632 + 1024 + 512 + 256 + 256 + 128 + 64;
  for (int it = blockIdx.x; it < NI; it += gridDim.x) {
    if (it < 1632) {
      transpose_tile(p.w_in + (size_t)l * 1024 * 10528, 10528, (it & 15) * 64, (it >> 4) * 64, 0, p.WinT, 1024, lds);
    } else if (it < 2656) {
      const int j = it - 1632;
      transpose_tile(p.w_in + (size_t)l * 1024 * 10528, 10528, (j & 15) * 64, (j >> 4) * 64, 1, p.WgT, 1024, lds);
    } else if (it < 3168) {
      const int j = it - 2656;
      const int n = j >> 7;
      transpose_tile(p.w_branch + ((size_t)(l * 4 + n) * 512) * 1024, 1024, (j & 7) * 64, ((j >> 3) & 15) * 64, 2,
                     p.WbT + (size_t)n * 1024 * 512, 512, lds);
    } else if (it < 3424) {
      const int j = it - 3168;
      transpose_tile(p.w_out + (size_t)l * 1024 * 1024, 1024, (j & 15) * 64, (j >> 4) * 64, 2, p.WoT, 1024, lds);
    } else if (it >= 3808) {
      const int j = it - 3808, kv = j >> 5, kc = j & 31;
      const int tid = TID(), n = tid & 127, kh = tid >> 7;
      const float* w1 = (kv ? p.cmp_v_w1 : p.cmp_k_w1) + (size_t)l * 2048 * 128;
      const float* pos = p.cmp_pos + l * 2048;
      float a = 0.f;
#pragma unroll 8
      for (int k = kc * 64 + kh * 32; k < kc * 64 + kh * 32 + 32; ++k) a += pos[k] * w1[(size_t)k * 128 + n];
      float* tmp = (float*)lds;
      tmp[tid] = a;
      __syncthreads();
      if (tid < 128) p.pospart[(size_t)(kv * 32 + kc) * 128 + tid] = tmp[tid] + tmp[tid + 128];
      __syncthreads();
    } else if (it >= 3680) {
      const int j = it - 3680;
      const int kv = j >> 6;
      transpose_tile((kv ? p.cmp_v_w1 : p.cmp_k_w1) + (size_t)l * 2048 * 128, 128, (j & 31) * 64, ((j >> 5) & 1) * 64, 2,
                     p.W1T + (size_t)kv * 128 * 2048, 2048, lds);
    } else {
      const int j = it - 3424;
      const int lane = TID() & 63, w = TID() >> 6;
      const float* g = p.norm_g + l * 1024;
      for (int i = 0; i < 16; ++i) {
        const int tok = j * 64 + w * 16 + i;
        const float* xr = xin + (size_t)tok * 1024;
        float4 v[4];
        float ss = 0.f;
#pragma unroll
        for (int q = 0; q < 4; ++q) {
          v[q] = *(const float4*)(xr + lane * 4 + 256 * q);
          ss += v[q].x * v[q].x + v[q].y * v[q].y + v[q].z * v[q].z + v[q].w * v[q].w;
        }
        ss = wave_sum(ss, lane);
        const float rs = rsqrtf(ss * (1.f / 1024.f) + 1e-6f);
#pragma unroll
        for (int q = 0; q < 4; ++q) {
          const float4 gg = *(const float4*)(g + lane * 4 + 256 * q);
          uint2 o;
          o.x = pk2(v[q].x * rs * gg.x, v[q].y * rs * gg.y);
          o.y = pk2(v[q].z * rs * gg.z, v[q].w * rs * gg.w);
          *(uint2*)(p.xn + (size_t)tok * 1024 + lane * 4 + 256 * q) = o;
        }
      }
    }
  }
}

DI void phase1(const Params& p, char* lds) {
  const int tid = TID(), lane = tid & 63, w = tid >> 6, wm = w >> 1, wn = w & 1, r = lane & 31, h = lane >> 5;
  for (int tile = blockIdx.x; tile < 128 * 51; tile += gridDim.x) {
    const int grp = tile / (32 * 51), rem = tile % (32 * 51);
    const int nt = rem >> 5, mt = grp * 32 + (rem & 31);
    f32x16 acc[2][2];
    zero_acc(acc);
    gemm_mainloop(p.xn + (size_t)mt * 128 * 1024, 1024, p.WinT + (size_t)nt * 128 * 1024, 1024, 1024, lds, acc);
#pragma unroll
    for (int mi = 0; mi < 2; ++mi) {
      const size_t row = (size_t)mt * 128 + wm * 64 + mi * 32 + r;
#pragma unroll
      for (int ni = 0; ni < 2; ++ni) {
#pragma unroll
        for (int a = 0; a < 4; ++a) {
          const int col = nt * 128 + wn * 64 + ni * 32 + 8 * a + 4 * h;
          uint2 o;
          o.x = pk2(acc[mi][ni][4 * a], acc[mi][ni][4 * a + 1]);
          o.y = pk2(acc[mi][ni][4 * a + 2], acc[mi][ni][4 * a + 3]);
          *(uint2*)(p.z + row * ZS + col) = o;
        }
      }
    }
  }
}

DI void phase4(const Params& p, char* lds) {
  const int tid = TID(), lane = tid & 63, w = tid >> 6, wm = w >> 1, wn = w & 1, r = lane & 31, h = lane >> 5;
  for (int tile = blockIdx.x; tile < 128 * 8; tile += gridDim.x) {
    const int nt = tile & 7, mt = tile >> 3;
    f32x16 mg[2][2];
    zero_acc(mg);
#pragma unroll 1
    for (int n = 0; n < 4; ++n) {
      f32x16 acc[2][2];
      zero_acc(acc);
      gemm_mainloop_shallow(p.xn + (size_t)mt * 128 * 1024, 1024, p.WgT + ((size_t)n * 1024 + nt * 128) * 1024, 1024, 1024, lds,
                    acc);
      uint4* scr = p.blkscr + (size_t)blockIdx.x * 8 * 256 + tid;
#pragma unroll
      for (int a = 0; a < 2; ++a)
#pragma unroll
        for (int b = 0; b < 2; ++b)
#pragma unroll
          for (int i = 0; i < 2; ++i) {
            uint4 o;
            o.x = pk2(sigmoidf_(acc[a][b][8 * i]), sigmoidf_(acc[a][b][8 * i + 1]));
            o.y = pk2(sigmoidf_(acc[a][b][8 * i + 2]), sigmoidf_(acc[a][b][8 * i + 3]));
            o.z = pk2(sigmoidf_(acc[a][b][8 * i + 4]), sigmoidf_(acc[a][b][8 * i + 5]));
            o.w = pk2(sigmoidf_(acc[a][b][8 * i + 6]), sigmoidf_(acc[a][b][8 * i + 7]));
            scr[((a * 2 + b) * 2 + i) * 256] = o;
          }
      zero_acc(acc);
      const int yoff = (n == 0) ? GA : ((n == 1) ? GB : ((n == 2) ? GC : GD));
      gemm_mainloop_shallow(p.z + (size_t)mt * 128 * ZS + yoff, ZS, p.WbT + ((size_t)n * 1024 + nt * 128) * 512, 512, 512, lds,
                    acc);
#pragma unroll
      for (int a = 0; a < 2; ++a)
#pragma unroll
        for (int b = 0; b < 2; ++b)
#pragma unroll
          for (int i = 0; i < 2; ++i) {
            const uint4 o = scr[((a * 2 + b) * 2 + i) * 256];
            mg[a][b][8 * i] += bflo(o.x) * acc[a][b][8 * i];
            mg[a][b][8 * i + 1] += bfhi(o.x) * acc[a][b][8 * i + 1];
            mg[a][b][8 * i + 2] += bflo(o.y) * acc[a][b][8 * i + 2];
            mg[a][b][8 * i + 3] += bfhi(o.y) * acc[a][b][8 * i + 3];
            mg[a][b][8 * i + 4] += bflo(o.z) * acc[a][b][8 * i + 4];
            mg[a][b][8 * i + 5] += bfhi(o.z) * acc[a][b][8 * i + 5];
            mg[a][b][8 * i + 6] += bflo(o.w) * acc[a][b][8 * i + 6];
            mg[a][b][8 * i + 7] += bfhi(o.w) * acc[a][b][8 * i + 7];
          }
    }
#pragma unroll
    for (int mi = 0; mi < 2; ++mi) {
      const size_t row = (size_t)mt * 128 + wm * 64 + mi * 32 + r;
#pragma unroll
      for (int ni = 0; ni < 2; ++ni)
#pragma unroll
        for (int a = 0; a < 4; ++a) {
          const int col = nt * 128 + wn * 64 + ni * 32 + 8 * a + 4 * h;
          uint2 o;
          o.x = pk2(mg[mi][ni][4 * a], mg[mi][ni][4 * a + 1]);
          o.y = pk2(mg[mi][ni][4 * a + 2], mg[mi][ni][4 * a + 3]);
          *(uint2*)(p.z + row * ZS + col) = o;
        }
    }
  }
}

DI void phase5(const Params& p, const float* xin, float* xout, char* lds) {
  const int tid = TID(), lane = tid & 63, w = tid >> 6, wm = w >> 1, wn = w & 1, r = lane & 31, h = lane >> 5;
  for (int tile = blockIdx.x; tile < 128 * 8; tile += gridDim.x) {
    const int nt = tile & 7, mt = tile >> 3;
    f32x16 acc[2][2];
    zero_acc(acc);
    gemm_mainloop(p.z + (size_t)mt * 128 * ZS, ZS, p.WoT + (size_t)nt * 128 * 1024, 1024, 1024, lds, acc);
#pragma unroll
    for (int mi = 0; mi < 2; ++mi) {
      const size_t row = (size_t)mt * 128 + wm * 64 + mi * 32 + r;
#pragma unroll
      for (int ni = 0; ni < 2; ++ni)
#pragma unroll
        for (int a = 0; a < 4; ++a) {
          const int col = nt * 128 + wn * 64 + ni * 32 + 8 * a + 4 * h;
          float4 xv = *(const float4*)(xin + row * 1024 + col);
          xv.x += acc[mi][ni][4 * a];
          xv.y += acc[mi][ni][4 * a + 1];
          xv.z += acc[mi][ni][4 * a + 2];
          xv.w += acc[mi][ni][4 * a + 3];
          *(float4*)(xout + row * 1024 + col) = xv;
        }
    }
  }
}

DI void compress_item(const Params& p, int l, int item, char* lds) {
  const int kv = item & 1, half = (item >> 1) & 1, g = (item >> 2) & 1, b = item >> 3;
  const int tid = TID(), lane = tid & 63, w = tid >> 6, wm = w >> 1, wn = w & 1, r = lane & 31, h = lane >> 5;
  const float* w2 = (kv ? p.cmp_v_w2 : p.cmp_k_w2) + (size_t)l * 128 * 64;
  float* posw = (float*)lds;
  {
    if (tid < 128) {
      float a = 0.f;
#pragma unroll 8
      for (int kc = 0; kc < 32; ++kc) a += p.pospart[(size_t)(kv * 32 + kc) * 128 + tid];
      posw[tid] = a;
    }
    __syncthreads();
  }
  float pw[2][16];
#pragma unroll
  for (int ni = 0; ni < 2; ++ni)
#pragma unroll
    for (int i = 0; i < 16; ++i) pw[ni][i] = posw[wn * 64 + ni * 32 + (i & 3) + 8 * (i >> 2) + 4 * h];
  __syncthreads();
  f32x16 acc[2][2];
  zero_acc(acc);
  const u16* Ag = p.z + ((size_t)b * S_ + 16 * (half * 128)) * ZS + (kv ? VCC : KCC) + g * 64;
  gemm_mainloop(Ag, 16 * ZS, p.W1T + (size_t)kv * 128 * 2048, 2048, 2048, lds, acc, ZS);
  float* hid = (float*)lds;
#pragma unroll
  for (int mi = 0; mi < 2; ++mi)
#pragma unroll
    for (int ni = 0; ni < 2; ++ni)
#pragma unroll
      for (int i = 0; i < 16; ++i) {
        const int row = wm * 64 + mi * 32 + r, col = wn * 64 + ni * 32 + (i & 3) + 8 * (i >> 2) + 4 * h;
        hid[row * 132 + col] = siluf_(acc[mi][ni][i] + pw[ni][i]);
      }
  __syncthreads();
  {
    const int e = tid & 63, rq = tid >> 6;
    float o[32];
#pragma unroll
    for (int i = 0; i < 32; ++i) o[i] = 0.f;
    for (int n = 0; n < 128; n += 4) {
      const float w0 = w2[n * 64 + e], w1v = w2[(n + 1) * 64 + e], w2v = w2[(n + 2) * 64 + e], w3 = w2[(n + 3) * 64 + e];
#pragma unroll
      for (int i = 0; i < 32; ++i) {
        const float4 hv = *(const float4*)(hid + (rq * 32 + i) * 132 + n);
        o[i] += hv.x * w0 + hv.y * w1v + hv.z * w2v + hv.w * w3;
      }
    }
    const float gk = p.kn_c[l * 64 + e];
#pragma unroll
    for (int i = 0; i < 32; ++i) {
      const int c = half * 128 + rq * 32 + i;
      float v = o[i];
      if (kv == 0) {
        const float ss = wave_sum(v * v, lane);
        v = v * rsqrtf(ss * (1.f / 64.f) + 1e-6f) * gk;
      }
      if (c >= 255) v = 0.f;
      u16* dst = (kv ? p.vc : p.kc) + ((size_t)(b * 2 + g) * 256 + c) * 64 + e;
      *dst = f2bf(v);
    }
  }
}

DI void lru_item(const Params& p, int l, int item, int pass, char* lds, int dry = 0) {
  const int n = item & 7, chunk = (item >> 3) & 63, b = item >> 9;
  u16* X = (u16*)lds;
  u16* Wa = X + 64 * 72;
  u16* Wx = Wa + 64 * 72;
  float* preA = (float*)(lds + 3 * 64 * 72 * 2);
  float* preX = preA + 64 * 64;
  float* segP = preX + 64 * 64;
  float* segH = segP + 256;
  float* carA = segH + 256;
  float* carB = carA + 256;
  const int tid = TID(), ch = tid & 63, tq = tid >> 6;
  const int chg = n * 64 + ch;
  const int t0 = chunk * 64 + tq * 16;
  const u16* zb = p.z + (size_t)b * S_ * ZS + XB + chg;
  const float* cw = p.conv_w + l * 4 * 512;
  const float w0 = cw[chg], w1 = cw[512 + chg], w2 = cw[1024 + chg], w3 = cw[1536 + chg];
  const float cb = p.conv_b[l * 512 + chg];
  float xm3 = (t0 >= 3) ? bf2f(zb[(size_t)(t0 - 3) * ZS]) : 0.f;
  float xm2 = (t0 >= 2) ? bf2f(zb[(size_t)(t0 - 2) * ZS]) : 0.f;
  float xm1 = (t0 >= 1) ? bf2f(zb[(size_t)(t0 - 1) * ZS]) : 0.f;
  float xc[16];
#pragma unroll
  for (int i = 0; i < 16; ++i) {
    const float cur = bf2f(zb[(size_t)(t0 + i) * ZS]);
    xc[i] = cb + w0 * xm3 + w1 * xm2 + w2 * xm1 + w3 * cur;
    xm3 = xm2; xm2 = xm1; xm1 = cur;
    X[(tq * 16 + i) * 72 + ch] = f2bf(xc[i]);
  }
  {
    const float4* ga = (const float4*)(p.w_rg_a + ((size_t)(l * 8 + n) * 64) * 64);
    const float4* gx = (const float4*)(p.w_rg_x + ((size_t)(l * 8 + n) * 64) * 64);
#pragma unroll
    for (int i = 0; i < 4; ++i) {
      const int idx = tid + 256 * i, d = idx >> 4, e = (idx & 15) * 4;
      const float4 va = ga[idx], vx = gx[idx];
      uint2 oa, ox;
      oa.x = pk2(va.x, va.y); oa.y = pk2(va.z, va.w);
      ox.x = pk2(vx.x, vx.y); ox.y = pk2(vx.z, vx.w);
      *(uint2*)(Wa + d * 72 + e) = oa;
      *(uint2*)(Wx + d * 72 + e) = ox;
    }
  }
  __syncthreads();
  {
    const int lane = tid & 63, r = lane & 31, h = lane >> 5, mt = tq >> 1, nt = tq & 1;
    const int q4 = (lane & 15) >> 2, p4 = lane & 3, blk = (lane >> 4) & 1;
    f32x16 accA, accX;
#pragma unroll
    for (int i = 0; i < 16; ++i) { accA[i] = 0.f; accX[i] = 0.f; }
#pragma unroll
    for (int ks = 0; ks < 4; ++ks) {
      const bf16x8 af = *(const bf16x8*)(X + (mt * 32 + r) * 72 + ks * 16 + 8 * h);
      const int woff = (ks * 16 + 8 * h + q4) * 72 + nt * 32 + 16 * blk + 4 * p4;
      const s16x4 alo = __builtin_amdgcn_ds_read_tr16_b64_v4i16((__attribute__((address_space(3))) s16x4*)(Wa + woff));
      const s16x4 ahi = __builtin_amdgcn_ds_read_tr16_b64_v4i16((__attribute__((address_space(3))) s16x4*)(Wa + woff + 4 * 72));
      const s16x4 xlo = __builtin_amdgcn_ds_read_tr16_b64_v4i16((__attribute__((address_space(3))) s16x4*)(Wx + woff));
      const s16x4 xhi = __builtin_amdgcn_ds_read_tr16_b64_v4i16((__attribute__((address_space(3))) s16x4*)(Wx + woff + 4 * 72));
      const bf16x8 ba_ = __builtin_shufflevector(alo, ahi, 0, 1, 2, 3, 4, 5, 6, 7);
      const bf16x8 bx_ = __builtin_shufflevector(xlo, xhi, 0, 1, 2, 3, 4, 5, 6, 7);
      accA = MFMA(af, ba_, accA);
      accX = MFMA(af, bx_, accX);
    }
#pragma unroll
    for (int i = 0; i < 16; ++i) {
      const int t = mt * 32 + (i & 3) + 8 * (i >> 2) + 4 * h;
      preA[t * 64 + nt * 32 + r] = accA[i];
      preX[t * 64 + nt * 32 + r] = accX[i];
    }
  }
  __syncthreads();
  float aA[16], aX[16];
#pragma unroll
  for (int i = 0; i < 16; ++i) { aA[i] = preA[(tq * 16 + i) * 64 + ch]; aX[i] = preX[(tq * 16 + i) * 64 + ch]; }
  const float ba = p.b_rg_a[l * 512 + chg], bx = p.b_rg_x[l * 512 + chg], lam = p.lru_lambda[l * 512 + chg];
  const float sp = fmaxf(-lam, 0.f) + __logf(1.f + __expf(-fabsf(lam)));
  float P = 1.f, H = 0.f;
#pragma unroll
  for (int i = 0; i < 16; ++i) {
    const float rr = sigmoidf_(aA[i] + ba), ig = sigmoidf_(aX[i] + bx);
    const float la = -8.f * rr * sp;
    const float a = __expf(la);
    const float x2 = 2.f * la;
    const float em = (x2 > -0.1f) ? -x2 * (1.f + x2 * (0.5f + x2 * (0.16666667f + x2 * 0.041666667f))) : 1.f - __expf(x2);
    const float bb = sqrtf(fmaxf(em, 0.f)) * ig * xc[i];
    aA[i] = a; aX[i] = bb;
    H = a * H + bb;
    P *= a;
  }
  segP[tq * 64 + ch] = P;
  segH[tq * 64 + ch] = H;
  __syncthreads();
  if (pass == 1) {
    if (tq == 3) {
      float Pt = 1.f, Ht = 0.f;
#pragma unroll
      for (int s = 0; s < 4; ++s) { Ht = segP[s * 64 + ch] * Ht + segH[s * 64 + ch]; Pt *= segP[s * 64 + ch]; }
      float2 o; o.x = Pt; o.y = Ht;
      *(float2*)(p.lrusum + ((size_t)(b * 64 + chunk) * 512 + chg) * 2) = o;
    }
  } else {
    {
      const int lo = (chunk * tq) >> 2, hi = (chunk * (tq + 1)) >> 2;
      float cA = 1.f, cB = 0.f;
#pragma unroll 4
      for (int c = lo; c < hi; ++c) {
        const float2 sm = *(const float2*)(p.lrusum + ((size_t)(b * 64 + c) * 512 + chg) * 2);
        cB = sm.x * cB + sm.y;
        cA *= sm.x;
      }
      carA[tq * 64 + ch] = cA;
      carB[tq * 64 + ch] = cB;
    }
    __syncthreads();
    float hh = 0.f;
#pragma unroll
    for (int s = 0; s < 4; ++s) hh = carA[s * 64 + ch] * hh + carB[s * 64 + ch];
    for (int s = 0; s < tq; ++s) hh = segP[s * 64 + ch] * hh + segH[s * 64 + ch];
    u16* zg = p.z + ((size_t)b * S_ + t0) * ZS + GB + chg;
#pragma unroll
    for (int i = 0; i < 16; ++i) {
      hh = aA[i] * hh + aX[i];
      const float gt = bf2f(zg[(size_t)i * ZS]);
      u16* dst = dry ? ((u16*)(p.blkscr + (size_t)blockIdx.x * 8 * 256 + tid) + (i & 7)) : (zg + (size_t)i * ZS);
      *dst = f2bf(hh * siluf_(gt));
    }
  }
}

DI void cumsum_item(const Params& p, int l, int item, char* lds) {
  const int hd = item & 7, b = item >> 3;
  float* part = (float*)lds;
  const int tid = TID();
  const float bfv = p.b_forget[l * 8 + hd];
  const u16* zf = p.z + ((size_t)b * S_ + tid * 16) * ZS + FA + hd;
  float v[16], run = 0.f;
#pragma unroll
  for (int i = 0; i < 16; ++i) {
    const float f = bf2f(zf[(size_t)i * ZS]) + bfv;
    const float ls = fminf(f, 0.f) - __logf(1.f + __expf(-fabsf(f)));
    run += ls;
    v[i] = run;
  }
  part[tid] = run;
  __syncthreads();
  float pre = 0.f;
  for (int i = 0; i < tid; ++i) pre += part[i];
  float* dst = p.cbuf + (size_t)(b * 8 + hd) * S_ + tid * 16;
#pragma unroll
  for (int i = 0; i < 16; ++i) dst[i] = (pre + v[i]) * LOG2E;
}

DI void headnorm_item(const Params& p, int l, int item, int dry = 0) {
  const int tid = TID();
  for (int i = 0; i < 7; ++i) {
    const int vid = tid + 256 * i;
    const int tokl = vid / 28, hv = vid % 28;
    const size_t tok = (size_t)item * 64 + tokl;
    int col; const float* g; float sc = 1.f;
    if (hv < 8) { col = QA + hv * 64; g = p.qn_a + l * 64; sc = QSCALE; }
    else if (hv < 16) { col = KA + (hv - 8) * 64; g = p.kn_a + l * 64; }
    else if (hv < 24) { col = QC + (hv - 16) * 64; g = p.qn_c + l * 64; sc = QSCALE; }
    else if (hv < 26) { col = KSC + (hv - 24) * 64; g = p.kn_c + l * 64; }
    else { col = KWC + (hv - 26) * 64; g = p.kn_c + l * 64; }
    uint4* ptr = (uint4*)(p.z + tok * ZS + col);
    uint4 v[8];
    float ss = 0.f;
#pragma unroll
    for (int q = 0; q < 8; ++q) {
      v[q] = ptr[q];
      const unsigned uu[4] = {v[q].x, v[q].y, v[q].z, v[q].w};
#pragma unroll
      for (int e = 0; e < 4; ++e) { const float a = bflo(uu[e]), c = bfhi(uu[e]); ss += a * a + c * c; }
    }
    const float rs = rsqrtf(ss * (1.f / 64.f) + 1e-6f) * sc;
#pragma unroll
    for (int q = 0; q < 8; ++q) {
      const unsigned uu[4] = {v[q].x, v[q].y, v[q].z, v[q].w};
      unsigned oo[4];
#pragma unroll
      for (int e = 0; e < 4; ++e)
        oo[e] = pk2(bflo(uu[e]) * rs * g[q * 8 + 2 * e], bfhi(uu[e]) * rs * g[q * 8 + 2 * e + 1]);
      uint4* dp = dry ? (p.blkscr + (size_t)blockIdx.x * 8 * 256 + tid + (q & 7) * 256) : (ptr + q);
      *dp = make_uint4(oo[0], oo[1], oo[2], oo[3]);
    }
  }
}

DI void sgprep_item(const Params& p, int l, int item, int dry = 0) {
  const int lane = TID() & 63, w = TID() >> 6;
  const float* g = p.ln_v_g + l * 512 + lane * 8;
  for (int i = 0; i < 16; ++i) {
    const size_t tok = (size_t)item * 64 + w * 16 + i;
    uint4* ptr = (uint4*)(p.z + tok * ZS + VD + lane * 8);
    const uint4 v = *ptr;
    const unsigned uu[4] = {v.x, v.y, v.z, v.w};
    float f[8];
    float s = 0.f;
#pragma unroll
    for (int e = 0; e < 4; ++e) { f[2 * e] = geluf_(bflo(uu[e])); f[2 * e + 1] = geluf_(bfhi(uu[e])); s += f[2 * e] + f[2 * e + 1]; }
    const float mu = wave_sum(s, lane) * (1.f / 512.f);
    float q = 0.f;
#pragma unroll
    for (int e = 0; e < 8; ++e) { f[e] -= mu; q += f[e] * f[e]; }
    const float rs = rsqrtf(wave_sum(q, lane) * (1.f / 512.f) + 1e-6f);
    unsigned oo[4];
#pragma unroll
    for (int e = 0; e < 4; ++e) oo[e] = pk2(f[2 * e] * rs * g[2 * e], f[2 * e + 1] * rs * g[2 * e + 1]);
    uint4* dp = dry ? (p.blkscr + (size_t)blockIdx.x * 8 * 256 + TID()) : ptr;
    *dp = make_uint4(oo[0], oo[1], oo[2], oo[3]);
  }
}

DI void sg_item(const Params& p, int l, int item, char* lds, int dry) {
  const int g = item & 7, chunk = (item >> 3) & 31, b = item >> 8;
  u16* vn = (u16*)lds;
  const int tid = TID(), lane = tid & 63, w = tid >> 6, r = lane & 31, h = lane >> 5;
  const size_t tokbase = (size_t)b * S_ + chunk * 128;
#pragma unroll
  for (int i = 0; i < 4; ++i) {
    const int id = tid + 256 * i, row = id >> 3, c = id & 7;
    *(uint4*)(vn + row * 72 + c * 8) = *(const uint4*)(p.z + (tokbase + row) * ZS + VD + g * 64 + c * 8);
  }
  __syncthreads();
  const int t = 32 * w + r;
  const float* wr = p.w_spatial + (((size_t)(l * 8 + g) * 128) + t) * 128;
  const int q4 = (lane & 15) >> 2, p4 = lane & 3, blk = (lane >> 4) & 1;
  f32x16 acc[2];
#pragma unroll
  for (int i = 0; i < 16; ++i) { acc[0][i] = 0.f; acc[1][i] = 0.f; }
  const int nks = 2 * (w + 1);
  for (int ks = 0; ks < nks; ++ks) {
    const int s0 = ks * 16 + 8 * h;
    const float4 w0 = *(const float4*)(wr + s0);
    const float4 w1 = *(const float4*)(wr + s0 + 4);
    float wv[8] = {w0.x, w0.y, w0.z, w0.w, w1.x, w1.y, w1.z, w1.w};
#pragma unroll
    for (int j = 0; j < 8; ++j) wv[j] = (s0 + j <= t) ? wv[j] : 0.f;
    const uint4 uu = make_uint4(pk2(wv[0], wv[1]), pk2(wv[2], wv[3]), pk2(wv[4], wv[5]), pk2(wv[6], wv[7]));
    const bf16x8 bfr = __builtin_bit_cast(bf16x8, uu);
#pragma unroll
    for (int db = 0; db < 2; ++db) {
      const u16* vp = vn + (ks * 16 + 8 * h + q4) * 72 + db * 32 + 16 * blk + 4 * p4;
      const s16x4 lo = __builtin_amdgcn_ds_read_tr16_b64_v4i16((__attribute__((address_space(3))) s16x4*)(vp));
      const s16x4 hi = __builtin_amdgcn_ds_read_tr16_b64_v4i16((__attribute__((address_space(3))) s16x4*)(vp + 4 * 72));
      const bf16x8 afr = __builtin_shufflevector(lo, hi, 0, 1, 2, 3, 4, 5, 6, 7);
      acc[db] = MFMA(afr, bfr, acc[db]);
    }
  }
  const float bsv = p.b_spatial[(l * 8 + g) * 128 + t];
  u16* zr = p.z + (tokbase + t) * ZS;
#pragma unroll
  for (int db = 0; db < 2; ++db)
#pragma unroll
    for (int a4 = 0; a4 < 4; ++a4) {
      const int d = db * 32 + 8 * a4 + 4 * h;
      const uint2 uv = *(const uint2*)(zr + UD + g * 64 + d);
      uint2* gp = (uint2*)(zr + GD + g * 64 + d);
      const uint2 gv = *gp;
      uint2 o;
      o.x = pk2(geluf_(bflo(uv.x)) * (acc[db][4 * a4] + bsv) * siluf_(bflo(gv.x)),
                geluf_(bfhi(uv.x)) * (acc[db][4 * a4 + 1] + bsv) * siluf_(bfhi(gv.x)));
      o.y = pk2(geluf_(bflo(uv.y)) * (acc[db][4 * a4 + 2] + bsv) * siluf_(bflo(gv.y)),
                geluf_(bfhi(uv.y)) * (acc[db][4 * a4 + 3] + bsv) * siluf_(bfhi(gv.y)));
      if (dry) gp = (uint2*)(p.blkscr + (size_t)blockIdx.x * 8 * 256 + tid + ((db * 4 + a4) >> 1) * 256) + (a4 & 1);
      *gp = o;
    }
}

#define LDK 72
#define OFF_CK 36864
#define OFF_IMP 37376
#define OFF_SEL (OFF_IMP + 64 * 65 * 4)
#define OFF_WUNI (OFF_SEL + 512)
#define OFF_TL (OFF_WUNI + 64)
enum { M_FOX = 0, M_CMP = 1, M_CMP2 = 2, M_SLC = 3, M_WIN = 4 };

template <int MODE>
DI void attn_run(char* lds, const u16* __restrict__ Kg, const u16* __restrict__ Vg, int kstride,
                 const float* __restrict__ cgl, int nt, int first_tile, const bf16x8 (&qf)[2][4], f32x16 (&O)[2][2],
                 float (&m)[2], float (&l)[2], const int (&qpos)[2], const float (&cq)[2], const u64 (&selb)[2],
                 const float (&linv)[2], int wq0) {
  const int tid = TID(), lane = tid & 63, w = tid >> 6, r = lane & 31, h = lane >> 5;
  u16* Ks = (u16*)lds;
  u16* Vs = Ks + 2 * 64 * LDK;
  float* cks = (float*)(lds + OFF_CK);
  float* imp = (float*)(lds + OFF_IMP);
  const int* tlist = (const int*)(lds + OFF_TL);
  uint4 rk0, rk1, rv0 = make_uint4(0, 0, 0, 0), rv1 = make_uint4(0, 0, 0, 0);
  float rc = 0.f;
  const int lrow = tid >> 3, lcc = tid & 7;
  const int q4 = (lane & 15) >> 2, p4 = lane & 3, blk = (lane >> 4) & 1;

#define KEY0_OF(i_) ((MODE == M_SLC) ? tlist[(i_)] * 64 : ((MODE == M_FOX) ? (nt - 1 - (i_)) * 64 : (first_tile + (i_)) * 64))
#define ALOAD(i_)                                                                               \
  {                                                                                             \
    const int k0_ = KEY0_OF(i_);                                                                \
    rk0 = *(const uint4*)(Kg + (size_t)(k0_ + lrow) * kstride + lcc * 8);                       \
    rk1 = *(const uint4*)(Kg + (size_t)(k0_ + lrow + 32) * kstride + lcc * 8);                  \
    if (MODE != M_CMP2) {                                                                       \
      rv0 = *(const uint4*)(Vg + (size_t)(k0_ + lrow) * kstride + lcc * 8);                     \
      rv1 = *(const uint4*)(Vg + (size_t)(k0_ + lrow + 32) * kstride + lcc * 8);                \
    }                                                                                           \
    if (MODE == M_FOX && tid < 64) rc = cgl[k0_ + tid];                                         \
  }
#define ASTORE(b_)                                                                              \
  {                                                                                             \
    *(uint4*)(Ks + (b_) * 64 * LDK + lrow * LDK + lcc * 8) = rk0;                               \
    *(uint4*)(Ks + (b_) * 64 * LDK + (lrow + 32) * LDK + lcc * 8) = rk1;                        \
    if (MODE != M_CMP2) {                                                                       \
      *(uint4*)(Vs + (b_) * 64 * LDK + lrow * LDK + lcc * 8) = rv0;                             \
      *(uint4*)(Vs + (b_) * 64 * LDK + (lrow + 32) * LDK + lcc * 8) = rv1;                      \
    }                                                                                           \
    if (MODE == M_FOX && tid < 64) cks[(b_) * 64 + tid] = rc;                                   \
  }

  ALOAD(0);
  ASTORE(0);
  __syncthreads();
  for (int it = 0; it < nt; ++it) {
    if (it + 1 < nt) ALOAD(it + 1);
    const int key0 = KEY0_OF(it);
    const u16* Kt = Ks + (it & 1) * 64 * LDK;
    const u16* Vt = Vs + (it & 1) * 64 * LDK;
    const float* ckt = cks + (it & 1) * 64;
#pragma unroll 1
    for (int kb = 0; kb < 2; ++kb) {
      const int kbase = key0 + kb * 32;
      bool need = true;
      if (MODE == M_FOX || MODE == M_SLC) need = (kbase <= wq0 + 63);
      if (MODE == M_WIN) need = (kbase <= wq0 + 63) && (kbase + 31 > wq0 - 512);
      if (MODE == M_CMP) need = (16 * kbase + 31 <= wq0 + 63);
      float mainv[2][4], spill[2][4];
      if (need) {
        bool domask = true;
        if (MODE == M_FOX || MODE == M_SLC) domask = (kbase + 31 > wq0);
        if (MODE == M_WIN) domask = (kbase + 31 > wq0) || (kbase <= wq0 + 63 - 512);
        bf16x8 pk[2][2];
#pragma unroll
        for (int nb = 0; nb < 2; ++nb) {
          f32x16 Sn;
          if (MODE == M_FOX) {
#pragma unroll
            for (int a4 = 0; a4 < 4; ++a4) {
              const float4 c4 = *(const float4*)(ckt + kb * 32 + 8 * a4 + 4 * h);
              Sn[4 * a4] = cq[nb] - c4.x; Sn[4 * a4 + 1] = cq[nb] - c4.y; Sn[4 * a4 + 2] = cq[nb] - c4.z; Sn[4 * a4 + 3] = cq[nb] - c4.w;
            }
          } else {
#pragma unroll
            for (int i = 0; i < 16; ++i) Sn[i] = 0.f;
          }
#pragma unroll
          for (int ks = 0; ks < 4; ++ks) {
            const bf16x8 a = *(const bf16x8*)(Kt + (kb * 32 + r) * LDK + ks * 16 + 8 * h);
            Sn = MFMA(a, qf[nb][ks], Sn);
          }
          float sv[16];
          const int t = qpos[nb];
          bool sb = true;
          if (MODE == M_SLC) sb = (((selb[nb] >> (key0 >> 6)) & 1ull) != 0ull);
          if (domask) {
#pragma unroll
            for (int i = 0; i < 16; ++i) {
              const int kk = kbase + (i & 3) + 8 * (i >> 2) + 4 * h;
              bool valid;
              if (MODE == M_FOX) valid = (kk <= t);
              else if (MODE == M_CMP || MODE == M_CMP2) valid = (16 * kk + 31 <= t) && (kk < 255);
              else if (MODE == M_SLC) valid = sb && (kk <= t);
              else valid = (kk <= t) && (kk > t - 512);
              sv[i] = valid ? Sn[i] : -INFINITY;
            }
          } else {
#pragma unroll
            for (int i = 0; i < 16; ++i) sv[i] = (MODE == M_SLC) ? (sb ? Sn[i] : -INFINITY) : Sn[i];
          }
          if (MODE == M_CMP2) {
#pragma unroll
            for (int a4 = 0; a4 < 4; ++a4) {
              float pe[4];
#pragma unroll
              for (int e = 0; e < 4; ++e) pe[e] = __builtin_amdgcn_exp2f(sv[4 * a4 + e] - m[nb]) * linv[nb];
              mainv[nb][a4] = pe[0] + pe[1] + pe[2] + 0.5f * pe[3];
              spill[nb][a4] = 0.5f * pe[3];
            }
          } else {
            float mx = sv[0];
#pragma unroll
            for (int i = 1; i < 16; ++i) mx = fmaxf(mx, sv[i]);
            mx = fmaxf(mx, shx(mx, lane, 32));
            if (__any(mx > m[nb] + 8.f)) {
              const float mnew = (mx > m[nb] + 8.f) ? mx : m[nb];
              const float alpha = __builtin_amdgcn_exp2f(m[nb] - mnew);
              m[nb] = mnew;
              l[nb] *= alpha;
#pragma unroll
              for (int i = 0; i < 16; ++i) { O[0][nb][i] *= alpha; O[1][nb][i] *= alpha; }
            }
            const float mc = m[nb];
            float ps = 0.f;
#pragma unroll
            for (int i = 0; i < 16; ++i) {
              sv[i] = __builtin_amdgcn_exp2f(sv[i] - mc);
              ps += sv[i];
            }
            l[nb] += ps;
#pragma unroll
            for (int s2 = 0; s2 < 2; ++s2) {
              const unsigned u0 = pk2(sv[8 * s2], sv[8 * s2 + 1]), u1 = pk2(sv[8 * s2 + 2], sv[8 * s2 + 3]);
              const unsigned u2 = pk2(sv[8 * s2 + 4], sv[8 * s2 + 5]), u3 = pk2(sv[8 * s2 + 6], sv[8 * s2 + 7]);
              const uint4 uu = make_uint4(u0, u1, u2, u3);
              pk[nb][s2] = __builtin_bit_cast(bf16x8, uu);
            }
          }
        }
        if (MODE != M_CMP2) {
#pragma unroll
          for (int s2 = 0; s2 < 2; ++s2) {
#pragma unroll
            for (int db = 0; db < 2; ++db) {
              const u16* vp = Vt + (kb * 32 + 16 * s2 + 4 * h + q4) * LDK + db * 32 + 16 * blk + 4 * p4;
              const s16x4 lo = __builtin_amdgcn_ds_read_tr16_b64_v4i16((__attribute__((address_space(3))) s16x4*)(vp));
              const s16x4 hi = __builtin_amdgcn_ds_read_tr16_b64_v4i16((__attribute__((address_space(3))) s16x4*)(vp + 8 * LDK));
              const bf16x8 a = __builtin_shufflevector(lo, hi, 0, 1, 2, 3, 4, 5, 6, 7);
              O[db][0] = MFMA(a, pk[0][s2], O[db][0]);
              O[db][1] = MFMA(a, pk[1][s2], O[db][1]);
            }
          }
        }
      }
      if (MODE == M_CMP2) {
        const int jb = (kbase >> 2) + h;
        for (int rr = 0; rr < 4; ++rr) {
          if (w == rr) {
#pragma unroll
            for (int nb = 0; nb < 2; ++nb)
#pragma unroll
              for (int a4 = 0; a4 < 4; ++a4) imp[(nb * 32 + r) * 65 + jb + 2 * a4] += mainv[nb][a4];
#pragma unroll
            for (int nb = 0; nb < 2; ++nb)
#pragma unroll
              for (int a4 = 0; a4 < 4; ++a4) imp[(nb * 32 + r) * 65 + jb + 2 * a4 + 1] += spill[nb][a4];
          }
          __syncthreads();
        }
      }
    }
    if (it + 1 < nt) ASTORE((it + 1) & 1);
    __syncthreads();
  }
#undef KEY0_OF
#undef ALOAD
#undef ASTORE
}

DI void attn_init(f32x16 (&O)[2][2], float (&m)[2], float (&l)[2]) {
#pragma unroll
  for (int a = 0; a < 2; ++a)
#pragma unroll
    for (int b = 0; b < 2; ++b)
#pragma unroll
      for (int i = 0; i < 16; ++i) O[a][b][i] = 0.f;
  m[0] = m[1] = NEGBIG;
  l[0] = l[1] = 0.f;
}

DI void fox_item(const Params& p, int l_, int item, char* lds, int dry) {
  const int qb = 15 - (item >> 5), bh = item & 31, b = bh >> 3, hd = bh & 7;
  const int tid = TID(), lane = tid & 63, w = tid >> 6, r = lane & 31, h = lane >> 5;
  const int wq0 = qb * 256 + w * 64;
  const int qpos[2] = {wq0 + r, wq0 + 32 + r};
  u16* zb = p.z + (size_t)b * S_ * ZS;
  bf16x8 qf[2][4];
#pragma unroll
  for (int nb = 0; nb < 2; ++nb)
#pragma unroll
    for (int ks = 0; ks < 4; ++ks)
      qf[nb][ks] = *(const bf16x8*)(zb + (size_t)qpos[nb] * ZS + QA + hd * 64 + ks * 16 + 8 * h);
  const float* cb = p.cbuf + (size_t)(b * 8 + hd) * S_;
  const float cq[2] = {cb[qpos[0]], cb[qpos[1]]};
  f32x16 O[2][2];
  float m[2], l[2];
  attn_init(O, m, l);
  const u64 selb[2] = {0ull, 0ull};
  const float linv[2] = {0.f, 0.f};
  attn_run<M_FOX>(lds, zb + KA + hd * 64, zb + VA + hd * 64, ZS, cb, 4 * (qb + 1), 0, qf, O, m, l, qpos, cq, selb, linv, wq0);
#pragma unroll
  for (int nb = 0; nb < 2; ++nb) {
    const float lt = l[nb] + shx(l[nb], lane, 32);
    const float inv = (lt > 0.f) ? 1.f / lt : 0.f;
    u16* zr = zb + (size_t)qpos[nb] * ZS + GA + hd * 64;
#pragma unroll
    for (int db = 0; db < 2; ++db)
#pragma unroll
      for (int a4 = 0; a4 < 4; ++a4) {
        uint2* gp = (uint2*)(zr + db * 32 + 8 * a4 + 4 * h);
        const uint2 gv = *gp;
        uint2 o;
        o.x = pk2(O[db][nb][4 * a4] * inv * siluf_(bflo(gv.x)), O[db][nb][4 * a4 + 1] * inv * siluf_(bfhi(gv.x)));
        o.y = pk2(O[db][nb][4 * a4 + 2] * inv * siluf_(bflo(gv.y)), O[db][nb][4 * a4 + 3] * inv * siluf_(bfhi(gv.y)));
        if (dry) gp = (uint2*)(p.blkscr + (size_t)blockIdx.x * 8 * 256 + tid + ((nb * 8 + db * 4 + a4) >> 1) * 256) + (a4 & 1);
        *gp = o;
      }
  }
}

DI void nsa_item(const Params& p, int l_, int item, char* lds, int dry) {
  const int qb = 63 - (item >> 3), bg = item & 7, b = bg >> 1, g = bg & 1;
  const int tid = TID(), lane = tid & 63, w = tid >> 6, r = lane & 31, h = lane >> 5;
  const int head = g * 4 + w;
  float* imp = (float*)(lds + OFF_IMP);
  u64* selm = (u64*)(lds + OFF_SEL);
  u64* wuni = (u64*)(lds + OFF_WUNI);
  int* tlist = (int*)(lds + OFF_TL);
  for (int i = tid; i < 64 * 65; i += 256) imp[i] = 0.f;
  const int wq0 = qb * 64;
  const int qpos[2] = {wq0 + r, wq0 + 32 + r};
  u16* zb = p.z + (size_t)b * S_ * ZS;
  bf16x8 qf[2][4];
#pragma unroll
  for (int nb = 0; nb < 2; ++nb)
#pragma unroll
    for (int ks = 0; ks < 4; ++ks)
      qf[nb][ks] = *(const bf16x8*)(zb + (size_t)qpos[nb] * ZS + QC + head * 64 + ks * 16 + 8 * h);
#define scr (p.blkscr + (size_t)blockIdx.x * 8 * 256 + TID())
#define NSA_GATE(c_, nb_) sigmoidf_(bf2f(zb[(size_t)qpos[nb_] * ZS + GATEC + (c_) * 8 + head]))
  const float cq[2] = {0.f, 0.f};
  u64 selb[2] = {0ull, 0ull};
  float linv[2] = {0.f, 0.f};
  f32x16 O[2][2];
  float m[2], l[2];

  attn_init(O, m, l);
  const u16* kcp = p.kc + (size_t)(b * 2 + g) * 256 * 64;
  const u16* vcp = p.vc + (size_t)(b * 2 + g) * 256 * 64;
  attn_run<M_CMP>(lds, kcp, vcp, 64, nullptr, 4, 0, qf, O, m, l, qpos, cq, selb, linv, wq0);
#pragma unroll
  for (int nb = 0; nb < 2; ++nb) {
    const float lt = l[nb] + shx(l[nb], lane, 32);
    linv[nb] = (lt > 0.f) ? 1.f / lt : 0.f;
    const float sc = linv[nb] * NSA_GATE(0, nb);
#pragma unroll
    for (int db = 0; db < 2; ++db)
#pragma unroll
      for (int i = 0; i < 2; ++i) {
        uint4 o;
        o.x = pk2(O[db][nb][8 * i] * sc, O[db][nb][8 * i + 1] * sc);
        o.y = pk2(O[db][nb][8 * i + 2] * sc, O[db][nb][8 * i + 3] * sc);
        o.z = pk2(O[db][nb][8 * i + 4] * sc, O[db][nb][8 * i + 5] * sc);
        o.w = pk2(O[db][nb][8 * i + 6] * sc, O[db][nb][8 * i + 7] * sc);
        scr[((nb * 2 + db) * 2 + i) * 256] = o;
      }
  }
  attn_run<M_CMP2>(lds, kcp, vcp, 64, nullptr, 4, 0, qf, O, m, l, qpos, cq, selb, linv, wq0);
  {
    u64 uni = 0ull;
    const int j = lane;
    const bool valid = (j <= qb);
    const bool forced = (j == 0) || (valid && j > qb - 2);
    for (int qq = 0; qq < 16; ++qq) {
      const int q = 16 * w + qq;
      const float sc = forced ? 1e6f : (valid ? imp[q * 65 + j] : -1.f);
      int rank = 0;
#pragma unroll
      for (int i = 0; i < 64; ++i) {
        const float si = __int_as_float(__builtin_amdgcn_readlane(__float_as_int(sc), i));
        rank += ((si > sc) || (si == sc && i < j)) ? 1 : 0;
      }
      const bool sel = (rank < 16) && (sc >= 0.f);
      const u64 mk = __ballot(sel);
      if (lane == 0) selm[q] = mk;
      uni |= mk;
    }
    if (lane == 0) wuni[w] = uni;
  }
  __syncthreads();
  const u64 U = wuni[0] | wuni[1] | wuni[2] | wuni[3];
  if (w == 0 && ((U >> lane) & 1ull)) tlist[__popcll(U & ((1ull << lane) - 1ull))] = lane;
  const int ntl = __popcll(U);
  selb[0] = selm[r];
  selb[1] = selm[32 + r];
  __syncthreads();
  attn_init(O, m, l);
  attn_run<M_SLC>(lds, zb + KSC + g * 64, zb + VSC + g * 64, ZS, nullptr, ntl, 0, qf, O, m, l, qpos, cq, selb, linv, wq0);
#pragma unroll
  for (int nb = 0; nb < 2; ++nb) {
    const float lt = l[nb] + shx(l[nb], lane, 32);
    const float sc = ((lt > 0.f) ? 1.f / lt : 0.f) * NSA_GATE(1, nb);
#pragma unroll
    for (int db = 0; db < 2; ++db)
#pragma unroll
      for (int i = 0; i < 2; ++i) {
        uint4 o = scr[((nb * 2 + db) * 2 + i) * 256];
        o.x = pk2(bflo(o.x) + O[db][nb][8 * i] * sc, bfhi(o.x) + O[db][nb][8 * i + 1] * sc);
        o.y = pk2(bflo(o.y) + O[db][nb][8 * i + 2] * sc, bfhi(o.y) + O[db][nb][8 * i + 3] * sc);
        o.z = pk2(bflo(o.z) + O[db][nb][8 * i + 4] * sc, bfhi(o.z) + O[db][nb][8 * i + 5] * sc);
        o.w = pk2(bflo(o.w) + O[db][nb][8 * i + 6] * sc, bfhi(o.w) + O[db][nb][8 * i + 7] * sc);
        scr[((nb * 2 + db) * 2 + i) * 256] = o;
      }
  }
  attn_init(O, m, l);
  const int first = (qb >= 8) ? qb - 8 : 0;
  attn_run<M_WIN>(lds, zb + KWC + g * 64, zb + VWC + g * 64, ZS, nullptr, qb - first + 1, first, qf, O, m, l, qpos, cq, selb, linv, wq0);
#pragma unroll
  for (int nb = 0; nb < 2; ++nb) {
    const float lt = l[nb] + shx(l[nb], lane, 32);
    const float sc = ((lt > 0.f) ? 1.f / lt : 0.f) * NSA_GATE(2, nb);
    u16* zr = zb + (size_t)qpos[nb] * ZS + GC + head * 64;
#pragma unroll
    for (int db = 0; db < 2; ++db)
#pragma unroll
      for (int a4 = 0; a4 < 4; ++a4) {
        uint2* gp = (uint2*)(zr + db * 32 + 8 * a4 + 4 * h);
        const uint2 gv = *gp;
        const uint2 pv = *((const uint2*)&scr[((nb * 2 + db) * 2 + (a4 >> 1)) * 256] + (a4 & 1));
        const unsigned o0 = pv.x, o1 = pv.y;
        uint2 o;
        o.x = pk2((bflo(o0) + O[db][nb][4 * a4] * sc) * siluf_(bflo(gv.x)),
                  (bfhi(o0) + O[db][nb][4 * a4 + 1] * sc) * siluf_(bfhi(gv.x)));
        o.y = pk2((bflo(o1) + O[db][nb][4 * a4 + 2] * sc) * siluf_(bflo(gv.y)),
                  (bfhi(o1) + O[db][nb][4 * a4 + 3] * sc) * siluf_(bfhi(gv.y)));
        if (dry) gp = (uint2*)&scr[((nb * 2 + db) * 2 + (a4 >> 1)) * 256] + (a4 & 1);
        *gp = o;
      }
  }
}

#undef scr
#define XB_TMO      128
#define XB_XCNT(j)  (256  + 64 * (j))
#define XB_XSUB(j)  (1280 + 64 * (j))
#define XB_XGEN(j)  (2304 + 64 * (j))
#define XB_TOP      3328
#define XB_TOPGEN   3392
#define XCD_BAR_WORDS 3456
#define XB_SPIN_CAP (1u << 18)
#define LAS __attribute__((address_space(3)))

__device__ __forceinline__ unsigned xb_ld(unsigned* p)              { return __hip_atomic_load(p, __ATOMIC_RELAXED, __HIP_MEMORY_SCOPE_AGENT); }
__device__ __forceinline__ unsigned xb_add(unsigned* p, unsigned v) { return __hip_atomic_fetch_add(p, v, __ATOMIC_RELAXED, __HIP_MEMORY_SCOPE_AGENT); }
__device__ __forceinline__ unsigned xb_xcc_id() { return (unsigned)__builtin_amdgcn_s_getreg((3 << 11) | 20) & 0xFu; }
#define XB_SPIN(cond, bar) do { unsigned _sp = 0; while (cond) { __builtin_amdgcn_s_sleep(1); \
    if ((++_sp & 255u) == 0u) { if (xb_ld(&(bar)[XB_TMO])) break; if (_sp > XB_SPIN_CAP) { atomicAdd(&(bar)[XB_TMO], 1u); break; } } } } while (0)

struct XcdBarrier {
    unsigned* bar; unsigned x;
    volatile LAS unsigned* st;
};

__device__ __forceinline__ XcdBarrier xcd_barrier_post(unsigned* bar, volatile LAS unsigned* st) {
    XcdBarrier b; b.bar = bar; b.x = xb_xcc_id(); b.st = st;
    if (threadIdx.x == 0) (void)xb_add(&bar[XB_XCNT(b.x)], 1u);
    return b;
}
__device__ __forceinline__ void xcd_barrier_complete(unsigned* bar, unsigned x, unsigned& nloc, unsigned& nx) {
    const unsigned G = gridDim.x * gridDim.y * gridDim.z;
    unsigned sum, cnt, mine, sp = 0u;
    for (;;) {
        sum = 0u; cnt = 0u; mine = 0u;
#pragma unroll
        for (unsigned j = 0; j < 16; ++j) { const unsigned c = xb_ld(&bar[XB_XCNT(j)]); sum += c; cnt += (c > 0u) ? 1u : 0u; mine = (j == x) ? c : mine; }
        if (sum == G) break;
        __builtin_amdgcn_s_sleep(1);
        if ((++sp & 255u) == 0u) { if (xb_ld(&bar[XB_TMO])) break; if (sp > XB_SPIN_CAP) { atomicAdd(&bar[XB_TMO], 1u); break; } }
    }
    nloc = mine > 0u ? mine : 1u; nx = cnt > 0u ? cnt : 1u;
}

__device__ __forceinline__ void xcd_barrier(const XcdBarrier& b) {
    asm volatile("s_waitcnt vmcnt(0)" ::: "memory");
    __syncthreads();
    if (threadIdx.x == 0) {
        unsigned* bar = b.bar;
        __builtin_amdgcn_s_waitcnt(0);
        unsigned nloc = b.st[0], nx = b.st[1];
        if (nloc == 0u) { xcd_barrier_complete(bar, b.x, nloc, nx); b.st[0] = nloc; b.st[1] = nx; }
        const unsigned old = xb_add(&bar[XB_XSUB(b.x)], 1u);
        const unsigned gen = old / nloc;
        if (old + 1u == (gen + 1u) * nloc) {
            __builtin_amdgcn_fence(__ATOMIC_RELEASE, "agent");
            asm volatile("s_waitcnt vmcnt(0)" ::: "memory");
            const unsigned og = xb_add(&bar[XB_TOP], 1u);
            const unsigned tg = og / nx;
            if (og + 1u == (tg + 1u) * nx) xb_add(&bar[XB_TOPGEN], 1u);
            else XB_SPIN(xb_ld(&bar[XB_TOPGEN]) == tg, bar);
            __builtin_amdgcn_fence(__ATOMIC_ACQUIRE, "agent");
            xb_add(&bar[XB_XGEN(b.x)], 1u);
            asm volatile("s_waitcnt vmcnt(0)" ::: "memory");
        } else {
            XB_SPIN(xb_ld(&bar[XB_XGEN(b.x)]) == gen, bar);
            __builtin_amdgcn_fence(__ATOMIC_ACQUIRE, "agent");
            asm volatile("s_waitcnt vmcnt(0)" ::: "memory");
        }
    }
    __syncthreads();
}


__global__ void __launch_bounds__(256, 2) hybrid_fwd(Params p) {
  cg::grid_group grid = cg::this_grid();
  __shared__ __attribute__((aligned(16))) char lds[LDS_BYTES];
  __shared__ int slot;
  __shared__ uint4 xb_words;
  if (threadIdx.x == 0) xb_words = make_uint4(0u, 0u, 0u, 0u);
  __syncthreads();
  const XcdBarrier xb = xcd_barrier_post(p.bar, (volatile LAS unsigned*)&xb_words);
  for (int l = 0; l < 2; ++l) {
    const float* xin = (l == 0) ? p.x : p.out;
    for (int rep = 0; rep < REP_P0; ++rep) phase0(p, l, xin, lds);
    if (p.z == nullptr) grid.sync();
    xcd_barrier(xb);
    for (int rep = 0; rep < REP_P1; ++rep) phase1(p, lds);
    xcd_barrier(xb);
    {
      for (int rep = 0; rep < REP_P2; ++rep) {
        int* ctr = p.ctr + l * 2 + rep * 8;
        const int dry = (rep + 1 < REP_P2) ? 1 : 0;
        for (;;) {
          const int it = pop_item(ctr, &slot);
          if (it >= 2624) break;
          if (it < 32) { if (!dry || (P2_MASK & 1)) compress_item(p, l, it, lds); }
          else if (it < 2080) { if (!dry || (P2_MASK & 2)) lru_item(p, l, it - 32, 1, lds); }
          else if (it < 2112) { if (!dry || (P2_MASK & 4)) cumsum_item(p, l, it - 2080, lds); }
          else if (it < 2368) { if (!dry || (P2_MASK & 8)) headnorm_item(p, l, it - 2112, dry); }
          else { if (!dry || (P2_MASK & 16)) sgprep_item(p, l, it - 2368, dry); }
        }
      }
    }
    xcd_barrier(xb);
    {
      for (int rep = 0; rep < REP_P3; ++rep) {
        const int dry = (rep + 1 < REP_P3) ? 1 : 0;
        int* ctr = p.ctr + l * 2 + 1 + rep * 4;
        for (;;) {
          const int it = pop_item(ctr, &slot);
          if (it >= 1024) break;
          if (it < 512) { if (!dry || (P3_MASK & 1)) nsa_item(p, l, it, lds, dry); }
          else { if (!dry || (P3_MASK & 2)) fox_item(p, l, it - 512, lds, dry); }
        }
        int* ctr2 = p.ctr + 32 + l * 2 + rep * 4;
        for (;;) {
          const int it = pop_item(ctr2, &slot);
          if (it >= 3072) break;
          if (it < 2048) { if (!dry || (P3_MASK & 4)) lru_item(p, l, it, 2, lds, dry); }
          else { if (!dry || (P3_MASK & 8)) sg_item(p, l, it - 2048, lds, dry); }
        }
      }
    }
    xcd_barrier(xb);
    for (int rep = 0; rep < REP_P4; ++rep) phase4(p, lds);
    xcd_barrier(xb);
    for (int rep = 0; rep < ((l == 0) ? REP_P5 : 1); ++rep) phase5(p, xin, p.out, lds);
    if (l == 0) xcd_barrier(xb);
  }
}

extern "C" void kernel_launch(void* const* d_in, const int* in_sizes, int n_in, void* d_out, int out_size, void* d_ws,
                              size_t ws_size, hipStream_t stream) {
  static int grid_blocks = 0;
  if (!grid_blocks) {
    int dev = 0, cus = 0, per_cu = 0;
    hipGetDevice(&dev);
    hipDeviceGetAttribute(&cus, hipDeviceAttributeMultiprocessorCount, dev);
    hipOccupancyMaxActiveBlocksPerMultiprocessor(&per_cu, hybrid_fwd, 256, 0);
    if (per_cu > 2) per_cu = 2;
    if (per_cu < 1) per_cu = 1;
    grid_blocks = cus * per_cu;
  }
  Params p{};
  const float** f = (const float**)&p;
  for (int i = 0; i < 25; ++i) f[i] = (const float*)d_in[i];
  p.out = (float*)d_out;
  char* ws = (char*)d_ws;
  size_t off = 0;
  auto take = [&](size_t bytes) { char* r = ws + off; off += (bytes + 255) & ~(size_t)255; return r; };
  p.ctr = (int*)take(256);
  p.bar = (unsigned*)take((size_t)XCD_BAR_WORDS * 4);
  p.z = (u16*)take((size_t)T_ * ZS * 2);
  p.xn = (u16*)take((size_t)T_ * 1024 * 2);
  p.WinT = (u16*)take((size_t)6528 * 1024 * 2);
  p.WgT = (u16*)take((size_t)4096 * 1024 * 2);
  p.WbT = (u16*)take((size_t)4 * 1024 * 512 * 2);
  p.WoT = (u16*)take((size_t)1024 * 1024 * 2);
  p.cbuf = (float*)take((size_t)4 * 8 * S_ * 4);
  p.lrusum = (float*)take((size_t)4 * 64 * 512 * 2 * 4);
  p.kc = (u16*)take((size_t)4 * 2 * 256 * 64 * 2);
  p.vc = (u16*)take((size_t)4 * 2 * 256 * 64 * 2);
  p.W1T = (u16*)take((size_t)2 * 128 * 2048 * 2);
  p.pospart = (float*)take((size_t)2 * 32 * 128 * 4);
  p.blkscr = (uint4*)take((size_t)grid_blocks * 8 * 256 * 16);
  hipMemsetAsync(p.ctr, 0, 256 + (((size_t)XCD_BAR_WORDS * 4 + 255) & ~(size_t)255), stream);
  void* args[] = {&p};
  hipError_t e = hipLaunchCooperativeKernel((void*)hybrid_fwd, dim3(grid_blocks), dim3(256), args, 0, stream);
  if (e != hipSuccess) fprintf(stderr, "cooperative launch failed: %s (grid %d)\n", hipGetErrorString(e), grid_blocks);
}
```
